# Optimizing an MI355X kernel written in HIP

```python
import math
import jax, jax.numpy as jnp
from jax import lax
import numpy as np

D_MODEL = 2048
BATCH = 4
SEQ = 4096
DEPTH = 1

ATT_HEAD_DIM = 128
ATT_HEADS_PER_GROUP = 6
DILATED_GROUPS = ((128, 1), (512, 4), (2048, 16))
ATT_HEADS = ATT_HEADS_PER_GROUP * len(DILATED_GROUPS)
ATT_WIDTH = ATT_HEADS * ATT_HEAD_DIM
ATT_OUT_WIDTH = ATT_HEADS_PER_GROUP * ATT_HEAD_DIM
ATT_BLOCK = 128
ROPE_THETA = 10000.0
NEG_INF = -1e30

GLA_HEADS = 4
GLA_DK = D_MODEL // (2 * GLA_HEADS)
GLA_DV = D_MODEL // GLA_HEADS
GLA_K_WIDTH = GLA_HEADS * GLA_DK
GLA_V_WIDTH = GLA_HEADS * GLA_DV
GLA_GATE_RANK = 16
GLA_GATE_NORM = 16.0
GLA_CHUNK = 64

IN_WIDTH = 3 * ATT_WIDTH + 2 * GLA_K_WIDTH + 2 * GLA_V_WIDTH + GLA_GATE_RANK + 2 * D_MODEL

N_EXPERTS = 32
TOP_K = 4
D_FF_EXPERT = D_MODEL
SWIGLU_LIMIT = 7.0
SWIGLU_ALPHA = 1.702
MOE_BLOCK = 128

NORM_EPS = 1e-6

kernel_name = "hybrid_dilated_gla_moe_block"


def rmsnorm(x, g):
    xf = x.astype(jnp.float32)
    y = xf * lax.rsqrt(jnp.mean(xf * xf, axis=-1, keepdims=True) + NORM_EPS)
    return (y * g.astype(jnp.float32)).astype(x.dtype)


def rope(t, positions):
    dh = t.shape[-1]
    half = dh // 2
    inv_freq = ROPE_THETA ** (-jnp.arange(0, dh, 2, dtype=jnp.float32) / dh)
    ang = positions.astype(jnp.float32)[..., None] * inv_freq
    cos = jnp.cos(ang)[:, :, None, :]
    sin = jnp.sin(ang)[:, :, None, :]
    tf = t.astype(jnp.float32)
    t1, t2 = tf[..., :half], tf[..., half:]
    out = jnp.concatenate([t1 * cos - t2 * sin, t2 * cos + t1 * sin], axis=-1)
    return out.astype(t.dtype)


def dilated_window_attention(q, k, v, window, dilation):
    B, H, S, Dh = q.shape
    span = window // dilation
    L = S // dilation
    nb = -(-L // ATT_BLOCK)
    Lp = nb * ATT_BLOCK

    def classes(t):
        t = t.reshape(B, H, L, dilation, Dh).transpose(0, 1, 3, 2, 4)
        t = jnp.pad(t, ((0, 0), (0, 0), (0, 0), (0, Lp - L), (0, 0)))
        return t.reshape(B, H, dilation, nb, ATT_BLOCK, Dh)

    def with_prev(t):
        prev = jnp.pad(t, ((0, 0), (0, 0), (0, 0), (1, 0), (0, 0), (0, 0)))[:, :, :, :-1]
        return jnp.concatenate([prev, t], axis=4)

    qb = classes(q)
    kk = with_prev(classes(k))
    vv = with_prev(classes(v))
    s = jnp.einsum('bhrnqd,bhrnkd->bhrnqk', qb, kk) * (Dh ** -0.5)
    qi = jnp.arange(ATT_BLOCK)[None, :, None]
    kj = jnp.arange(2 * ATT_BLOCK)[None, None, :]
    blk = jnp.arange(nb)[:, None, None]
    dist = ATT_BLOCK + qi - kj
    valid = (dist >= 0) & (dist <= span) & ((blk - 1) * ATT_BLOCK + kj >= 0)
    s = jnp.where(valid, s, NEG_INF)
    m = jnp.max(s, axis=-1, keepdims=True)
    p = jnp.exp(s - m)
    l = jnp.sum(p, axis=-1, keepdims=True)
    o = jnp.einsum('bhrnqk,bhrnkd->bhrnqd', p, vv) / l
    lse = (m + jnp.log(l))[..., 0]
    o = o.reshape(B, H, dilation, Lp, Dh)[:, :, :, :L].transpose(0, 1, 3, 2, 4).reshape(B, H, S, Dh)
    lse = lse.reshape(B, H, dilation, Lp)[:, :, :, :L].transpose(0, 1, 3, 2).reshape(B, H, S)
    return o, lse


def gla_chunked(q, k, v, gk):
    B, H, S, dk = q.shape
    dv = v.shape[-1]
    C = GLA_CHUNK
    N = S // C
    q = q.reshape(B, H, N, C, dk) * (dk ** -0.5)
    k = k.reshape(B, H, N, C, dk)
    v = v.reshape(B, H, N, C, dv)
    b = jnp.cumsum(gk.reshape(B, H, N, C, dk), axis=3)
    b_ref = b[:, :, :, C // 2:C // 2 + 1]
    b_last = b[:, :, :, C - 1:]
    a = jnp.einsum('bhnid,bhnjd->bhnij', q * jnp.exp(b - b_ref), k * jnp.exp(b_ref - b))
    causal = jnp.tril(jnp.ones((C, C), dtype=bool))
    a = jnp.where(causal, a, 0.0)
    o_intra = jnp.einsum('bhnij,bhnje->bhnie', a, v)
    q_in = q * jnp.exp(b)
    k_st = k * jnp.exp(b_last - b)
    decay = jnp.exp(b_last[:, :, :, 0])

    def step(state, xs):
        qn, kn, vn, dn = xs
        o = jnp.einsum('bhcd,bhde->bhce', qn, state)
        state = dn[..., None] * state + jnp.einsum('bhcd,bhce->bhde', kn, vn)
        return state, o

    xs = (jnp.moveaxis(q_in, 2, 0), jnp.moveaxis(k_st, 2, 0), jnp.moveaxis(v, 2, 0), jnp.moveaxis(decay, 2, 0))
    _, o_inter = lax.scan(step, jnp.zeros((B, H, dk, dv), jnp.float32), xs)
    o = o_intra + jnp.moveaxis(o_inter, 0, 2)
    return o.reshape(B, H, S, dv)


def moe_ffn(h, w_router, b_router, w_mlp1, b_mlp1, w_mlp2, b_mlp2):
    B, S, D = h.shape
    T = B * S
    hf = h.reshape(T, D)
    logits = (hf @ w_router + b_router).astype(jnp.float32)
    top_vals, top_idx = lax.top_k(logits, TOP_K)
    gates = jax.nn.softmax(top_vals, axis=-1)
    ex = top_idx.reshape(-1).astype(jnp.int32)
    tok = jnp.arange(T * TOP_K, dtype=jnp.int32) // TOP_K
    gw = gates.reshape(-1)
    order = jnp.argsort(ex)
    ex_s, tok_s, gw_s = ex[order], tok[order], gw[order]
    counts = jnp.zeros((N_EXPERTS,), jnp.int32).at[ex].add(1)
    group_start = jnp.cumsum(counts) - counts
    padded = (counts + MOE_BLOCK - 1) // MOE_BLOCK * MOE_BLOCK
    padded_end = jnp.cumsum(padded)
    padded_start = padded_end - padded
    rank = jnp.arange(T * TOP_K, dtype=jnp.int32) - group_start[ex_s]
    dest = padded_start[ex_s] + rank
    R = T * TOP_K + N_EXPERTS * MOE_BLOCK
    n_blocks = R // MOE_BLOCK
    tok_buf = jnp.full((R,), T, jnp.int32).at[dest].set(tok_s)
    gw_buf = jnp.zeros((R,), h.dtype).at[dest].set(gw_s.astype(h.dtype))
    block_start = jnp.arange(n_blocks, dtype=jnp.int32) * MOE_BLOCK
    block_expert = jnp.minimum(jnp.searchsorted(padded_end, block_start, side='right'), N_EXPERTS - 1)
    h_pad = jnp.concatenate([hf, jnp.zeros((1, D), hf.dtype)], axis=0)

    def block_fn(args):
        rows, wts, e = args
        xb = h_pad[rows]
        z = xb @ w_mlp1[e] + b_mlp1[e]
        glu = jnp.minimum(z[:, :D_FF_EXPERT], SWIGLU_LIMIT)
        lin = jnp.clip(z[:, D_FF_EXPERT:], -SWIGLU_LIMIT, SWIGLU_LIMIT)
        act = glu * jax.nn.sigmoid(SWIGLU_ALPHA * glu) * (lin + 1.0)
        y = act @ w_mlp2[e] + b_mlp2[e]
        return y * wts[:, None]

    ys = lax.map(block_fn, (tok_buf.reshape(n_blocks, MOE_BLOCK), gw_buf.reshape(n_blocks, MOE_BLOCK), block_expert))
    out = jnp.zeros((T + 1, D), h.dtype).at[tok_buf].add(ys.reshape(R, D))
    return out[:T].reshape(B, S, D)


def setup_inputs(seed: int = 0) -> dict:
    key = jax.random.key(seed)
    ks = jax.random.split(key, 20)
    f32 = jnp.float32

    def nrm(k, shape, fan_in):
        return jax.random.normal(k, shape, f32) * (fan_in ** -0.5)

    x = jax.random.normal(ks[0], (BATCH, SEQ, D_MODEL), f32)
    offsets = jax.random.randint(ks[1], (BATCH, 1), 0, 1024, dtype=jnp.int32)
    positions = offsets + jnp.arange(SEQ, dtype=jnp.int32)[None, :]
    return {
        "x": x,
        "positions": positions,
        "g_mix": 1.0 + 0.02 * jax.random.normal(ks[2], (DEPTH, D_MODEL), f32),
        "w_in": nrm(ks[3], (DEPTH, D_MODEL, IN_WIDTH), D_MODEL),
        "w_gk_up": nrm(ks[4], (DEPTH, GLA_GATE_RANK, GLA_K_WIDTH), GLA_GATE_RANK),
        "b_gk": 0.1 * jax.random.normal(ks[5], (DEPTH, GLA_K_WIDTH), f32),
        "g_gla": 1.0 + 0.02 * jax.random.normal(ks[6], (DEPTH, GLA_DV), f32),
        "w_oa": nrm(ks[7], (DEPTH, ATT_OUT_WIDTH, D_MODEL), ATT_OUT_WIDTH),
        "w_ob": nrm(ks[8], (DEPTH, GLA_V_WIDTH, D_MODEL), GLA_V_WIDTH),
        "w_out": nrm(ks[9], (DEPTH, D_MODEL, D_MODEL), D_MODEL),
        "g_ffn": 1.0 + 0.02 * jax.random.normal(ks[10], (DEPTH, D_MODEL), f32),
        "w_router": nrm(ks[11], (DEPTH, D_MODEL, N_EXPERTS), D_MODEL),
        "b_router": 0.01 * jax.random.normal(ks[12], (DEPTH, N_EXPERTS), f32),
        "w_mlp1": nrm(ks[13], (DEPTH, N_EXPERTS, D_MODEL, 2 * D_FF_EXPERT), D_MODEL),
        "b_mlp1": 0.01 * jax.random.normal(ks[14], (DEPTH, N_EXPERTS, 2 * D_FF_EXPERT), f32),
        "w_mlp2": nrm(ks[15], (DEPTH, N_EXPERTS, D_FF_EXPERT, D_MODEL), D_FF_EXPERT),
        "b_mlp2": 0.01 * jax.random.normal(ks[16], (DEPTH, N_EXPERTS, D_MODEL), f32),
        "g_final": 1.0 + 0.02 * jax.random.normal(ks[17], (D_MODEL,), f32),
    }


def reference(x, positions, g_mix, w_in, w_gk_up, b_gk, g_gla, w_oa, w_ob, w_out,
              g_ffn, w_router, b_router, w_mlp1, b_mlp1, w_mlp2, b_mlp2, g_final):
    B, S, _ = x.shape
    split_sizes = [ATT_WIDTH, ATT_WIDTH, ATT_WIDTH, GLA_K_WIDTH, GLA_K_WIDTH, GLA_V_WIDTH,
                   GLA_V_WIDTH, GLA_GATE_RANK, D_MODEL, D_MODEL]
    split_idx = [int(i) for i in np.cumsum(split_sizes)[:-1]]
    for l in range(DEPTH):
        h = rmsnorm(x, g_mix[l])
        proj = h @ w_in[l]
        q_a, k_a, v_a, q_b, k_b, v_b, g_b, gk_low, gate_a, gate_b = jnp.split(proj, split_idx, axis=-1)

        q_a = rope(q_a.reshape(B, S, ATT_HEADS, ATT_HEAD_DIM), positions)
        k_a = rope(k_a.reshape(B, S, ATT_HEADS, ATT_HEAD_DIM), positions)
        v_a = v_a.reshape(B, S, ATT_HEADS, ATT_HEAD_DIM)
        outs, lses = [], []
        for gi, (window, dilation) in enumerate(DILATED_GROUPS):
            sl = slice(gi * ATT_HEADS_PER_GROUP, (gi + 1) * ATT_HEADS_PER_GROUP)
            qg = q_a[:, :, sl].transpose(0, 2, 1, 3).astype(jnp.float32)
            kg = k_a[:, :, sl].transpose(0, 2, 1, 3).astype(jnp.float32)
            vg = v_a[:, :, sl].transpose(0, 2, 1, 3).astype(jnp.float32)
            o_g, lse_g = dilated_window_attention(qg, kg, vg, window, dilation)
            outs.append(o_g)
            lses.append(lse_g)
        w_groups = jax.nn.softmax(jnp.stack(lses, axis=0), axis=0)
        o_a = jnp.sum(w_groups[..., None] * jnp.stack(outs, axis=0), axis=0)
        o_a = o_a.transpose(0, 2, 1, 3).reshape(B, S, ATT_OUT_WIDTH).astype(x.dtype)

        gk = jax.nn.log_sigmoid((gk_low @ w_gk_up[l] + b_gk[l]).astype(jnp.float32)) / GLA_GATE_NORM
        to_heads = lambda t, d: t.reshape(B, S, GLA_HEADS, d).transpose(0, 2, 1, 3).astype(jnp.float32)
        o_b = gla_chunked(to_heads(q_b, GLA_DK), to_heads(k_b, GLA_DK), to_heads(v_b, GLA_DV), to_heads(gk, GLA_DK))
        o_b = rmsnorm(o_b.transpose(0, 2, 1, 3), g_gla[l]).astype(x.dtype)
        o_b = (o_b * jax.nn.silu(g_b.reshape(B, S, GLA_HEADS, GLA_DV))).reshape(B, S, GLA_V_WIDTH)

        merged = jax.nn.sigmoid(gate_a) * (o_a @ w_oa[l]) + jax.nn.sigmoid(gate_b) * (o_b @ w_ob[l])
        x = x + merged @ w_out[l]

        x = x + moe_ffn(rmsnorm(x, g_ffn[l]), w_router[l], b_router[l], w_mlp1[l], b_mlp1[l], w_mlp2[l], b_mlp2[l])
    return rmsnorm(x, g_final)
```

```cpp
#include <hip/hip_runtime.h>
#include <hip/hip_bf16.h>
#include <cstdio>
#include <cstdint>

#define GAS __attribute__((address_space(1)))
#define LAS __attribute__((address_space(3)))
typedef unsigned short bf16_t;
typedef float f32x4 __attribute__((ext_vector_type(4)));
typedef float f32x2 __attribute__((ext_vector_type(2)));
typedef float f32x16 __attribute__((ext_vector_type(16)));
typedef short bf16x8 __attribute__((ext_vector_type(8)));
typedef unsigned u32x4 __attribute__((ext_vector_type(4)));
typedef unsigned u32x2 __attribute__((ext_vector_type(2)));

constexpr int T = 16384, DM = 2048, SEQ = 4096, NB = 4;
constexpr int ATT_W = 2304, ATT_OUT = 768, NHEAD = 18, HPG = 6;
constexpr int GLA_K = 1024, GLA_V = 2048, GLA_DK = 256, GLA_DV = 512;
constexpr int IN_W = 17168;
constexpr int C_QA = 0, C_KA = 2304, C_VA = 4608, C_QB = 6912, C_KB = 7936, C_VB = 8960, C_GB = 11008, C_GKL = 13056, C_GA = 13072, C_GBT = 15120;
constexpr int NPAD_IN = 17408;
constexpr int KCAT = 2816;
constexpr int NE = 32, TOPK = 4, DFF = 2048;
constexpr int RMAX = T * TOPK + NE * 256;
constexpr float NORM_EPS = 1e-6f;

constexpr size_t MiB = 1u << 20;
constexpr size_t WS_CTL = 0;
constexpr size_t CTL_ZERO_BYTES = 1 * MiB;
constexpr size_t WS_WIN = 1 * MiB;
constexpr size_t WS_WM = WS_WIN + 68 * MiB;
constexpr size_t WS_WO = WS_WM + 11 * MiB;
constexpr size_t WS_W1 = WS_WO + 8 * MiB;
constexpr size_t WS_W2 = WS_W1 + 512 * MiB;
constexpr size_t WS_H = WS_W2 + 256 * MiB;
constexpr size_t WS_QA = WS_H + 64 * MiB;
constexpr size_t WS_KA = WS_QA + 72 * MiB;
constexpr size_t WS_VA = WS_KA + 72 * MiB;
constexpr size_t WS_OG = WS_VA + 72 * MiB;
constexpr size_t WS_LSE = WS_OG + 72 * MiB;
constexpr size_t WS_QB = WS_LSE + 72 * MiB;
constexpr size_t WS_KB = WS_QB + 32 * MiB;
constexpr size_t WS_VB = WS_KB + 32 * MiB;
constexpr size_t WS_GB = WS_VB + 64 * MiB;
constexpr size_t WS_GR = WS_GB + 64 * MiB;
constexpr size_t WS_GS = WS_GR + 64 * MiB;
constexpr size_t WS_GKL = WS_GS + 64 * MiB;
constexpr size_t WS_COS = WS_GKL + 1 * MiB;
constexpr size_t WS_SIN = WS_COS + 4 * MiB;
constexpr size_t WS_OGLA = WS_SIN + 4 * MiB;
constexpr size_t WS_OCAT = WS_OGLA + 128 * MiB;
constexpr size_t WS_MRG = WS_OCAT + 88 * MiB;
constexpr size_t WS_H8 = WS_MRG;
constexpr size_t WS_WIN8 = WS_MRG + 32 * MiB;
constexpr size_t WS_X1 = WS_MRG + 64 * MiB;
constexpr size_t WS_H2 = WS_X1 + 128 * MiB;
constexpr size_t WS_WRH = WS_H2 + 64 * MiB;
constexpr size_t WS_WRL = WS_WRH + 128 * 1024;
constexpr size_t WS_TOPE = WS_WRH + 1 * MiB;
constexpr size_t WS_TOPG = WS_TOPE + 256 * 1024;
constexpr size_t WS_RANK = WS_TOPG + 256 * 1024;
constexpr size_t WS_SLOT = WS_RANK + 256 * 1024;
constexpr size_t WS_TOK = WS_SLOT + 256 * 1024;
constexpr size_t WS_GATE = WS_TOK + 512 * 1024;
constexpr size_t WS_TILEE = WS_GATE + 512 * 1024;
constexpr size_t WS_ACT = WS_TOPE + 4 * MiB;
constexpr size_t WS_Y = WS_ACT + 288 * MiB;
constexpr size_t WS_END = WS_Y + 288 * MiB;
constexpr int CW_BAR = 4096;
constexpr int CW_CNT = 16384;

constexpr int NWAVES = 8;
constexpr int LDS_BYTES = 163840;
constexpr int MISC_OFF = 131072 + 8192;

__device__ __forceinline__ unsigned cvtpk(float lo, float hi) { unsigned r; asm volatile("v_cvt_pk_bf16_f32 %0, %1, %2" : "=v"(r) : "v"(lo), "v"(hi)); return r; }
__device__ __forceinline__ float bf2f(unsigned short b) { return __uint_as_float(((unsigned)b) << 16); }
__device__ __forceinline__ float bflo(unsigned w) { return __uint_as_float(w << 16); }
__device__ __forceinline__ float bfhi(unsigned w) { return __uint_as_float(w & 0xffff0000u); }
__device__ __forceinline__ float wave_sum(float v) {
#pragma unroll
    for (int o = 1; o < 64; o <<= 1) v += __shfl_xor(v, o);
    return v;
}
__device__ __forceinline__ float sigmoidf_(float x) { return __builtin_amdgcn_rcpf(1.0f + __expf(-x)); }
#define XB_TMO      128
#define XB_XCNT(j)  (256  + 64 * (j))
#define XB_XSUB(j)  (1280 + 64 * (j))
#define XB_XGEN(j)  (2304 + 64 * (j))
#define XB_TOP      3328
#define XB_TOPGEN   3392
#define XCD_BAR_WORDS 3456
#define XB_SPIN_CAP (1u << 18)

__device__ __forceinline__ unsigned xb_ld(unsigned* p)              { return __hip_atomic_load(p, __ATOMIC_RELAXED, __HIP_MEMORY_SCOPE_AGENT); }
__device__ __forceinline__ unsigned xb_add(unsigned* p, unsigned v) { return __hip_atomic_fetch_add(p, v, __ATOMIC_RELAXED, __HIP_MEMORY_SCOPE_AGENT); }
__device__ __forceinline__ unsigned xb_xcc_id() { return (unsigned)__builtin_amdgcn_s_getreg((3 << 11) | 20) & 0xFu; }
#define XB_SPIN(cond, bar) do { unsigned _sp = 0; while (cond) { __builtin_amdgcn_s_sleep(1); \
    if ((++_sp & 255u) == 0u) { if (xb_ld(&(bar)[XB_TMO])) break; if (_sp > XB_SPIN_CAP) { atomicAdd(&(bar)[XB_TMO], 1u); break; } } } } while (0)

struct XcdBarrier {
    unsigned* bar; unsigned x;
    volatile LAS unsigned* st;
};

__device__ __forceinline__ XcdBarrier xcd_barrier_post(unsigned* bar, volatile LAS unsigned* st) {
    XcdBarrier b; b.bar = bar; b.x = xb_xcc_id(); b.st = st;
    if (threadIdx.x == 0) (void)xb_add(&bar[XB_XCNT(b.x)], 1u);
    return b;
}
__device__ __forceinline__ void xcd_barrier_complete(unsigned* bar, unsigned x, unsigned& nloc, unsigned& nx) {
    const unsigned G = gridDim.x * gridDim.y * gridDim.z;
    unsigned sum, cnt, mine, sp = 0u;
    for (;;) {
        sum = 0u; cnt = 0u; mine = 0u;
#pragma unroll
        for (unsigned j = 0; j < 16; ++j) { const unsigned c = xb_ld(&bar[XB_XCNT(j)]); sum += c; cnt += (c > 0u) ? 1u : 0u; mine = (j == x) ? c : mine; }
        if (sum == G) break;
        __builtin_amdgcn_s_sleep(1);
        if ((++sp & 255u) == 0u) { if (xb_ld(&bar[XB_TMO])) break; if (sp > XB_SPIN_CAP) { atomicAdd(&bar[XB_TMO], 1u); break; } }
    }
    nloc = mine > 0u ? mine : 1u; nx = cnt > 0u ? cnt : 1u;
}

__device__ __forceinline__ void xcd_barrier(const XcdBarrier& b) {
    asm volatile("s_waitcnt vmcnt(0)" ::: "memory");
    __syncthreads();
    if (threadIdx.x == 0) {
        unsigned* bar = b.bar;
        __builtin_amdgcn_s_waitcnt(0);
        unsigned nloc = b.st[0], nx = b.st[1];
        if (nloc == 0u) { xcd_barrier_complete(bar, b.x, nloc, nx); b.st[0] = nloc; b.st[1] = nx; }
        const unsigned old = xb_add(&bar[XB_XSUB(b.x)], 1u);
        const unsigned gen = old / nloc;
        if (old + 1u == (gen + 1u) * nloc) {
            __builtin_amdgcn_fence(__ATOMIC_RELEASE, "agent");
            asm volatile("s_waitcnt vmcnt(0)" ::: "memory");
            const unsigned og = xb_add(&bar[XB_TOP], 1u);
            const unsigned tg = og / nx;
            if (og + 1u == (tg + 1u) * nx) xb_add(&bar[XB_TOPGEN], 1u);
            else XB_SPIN(xb_ld(&bar[XB_TOPGEN]) == tg, bar);
            __builtin_amdgcn_fence(__ATOMIC_ACQUIRE, "agent");
            xb_add(&bar[XB_XGEN(b.x)], 1u);
            asm volatile("s_waitcnt vmcnt(0)" ::: "memory");
        } else {
            XB_SPIN(xb_ld(&bar[XB_XGEN(b.x)]) == gen, bar);
            __builtin_amdgcn_fence(__ATOMIC_ACQUIRE, "agent");
            asm volatile("s_waitcnt vmcnt(0)" ::: "memory");
        }
    }
    __syncthreads();
}
namespace att {
constexpr int D = 128;
constexpr float THR = 8.f;
constexpr bool WSKIP = true;
constexpr long long ATT_O_FROM_Q = (long long)WS_OG - (long long)WS_QA, ATT_LSE_FROM_Q = (long long)WS_LSE - (long long)WS_QA;
constexpr float SCALE = 0.08838834764831845f;
constexpr int NW = 8, QBLK = 32, KVBLK = 64, QB = NW * QBLK;
constexpr int SHM_V = KVBLK * D * 2, SHM_K = KVBLK * D * 2;
constexpr int LDS_BYTES = 2 * SHM_V + 2 * SHM_K + NW * 64 * 4;

using bf16 = __hip_bfloat16;
typedef short bf16x8 __attribute__((ext_vector_type(8)));
typedef short s16x4 __attribute__((ext_vector_type(4)));
typedef float f32x16 __attribute__((ext_vector_type(16)));
typedef float f32x4 __attribute__((ext_vector_type(4)));
typedef unsigned u32x4 __attribute__((ext_vector_type(4)));
template <class A, class Bt> struct same_t { static constexpr bool v = false; };
template <class A> struct same_t<A, A> { static constexpr bool v = true; };

#define KSWZ(row, colB) ((row) * 256 + ((colB) ^ (((row) & 7) << 4)))
#define SBAR() __builtin_amdgcn_sched_barrier(0)
__device__ __forceinline__ int v_st(int k, int c) { const int kk = (k & ~0xC) | ((k & 4) << 1) | ((k & 8) >> 1); return ((kk >> 3) * 4 + (c >> 5)) * 512 + ((kk & 7) * 32 + (c & 31)) * 2; }
__device__ __forceinline__ int v_rd_base(int lane) { return ((lane & 3) << 3) | (((lane >> 2) & 3) << 6) | (((lane >> 4) & 1) << 5) | (((lane >> 5) & 1) << 8); }
constexpr int v_rd_off(int d0, int ks, int half) { return d0 * 512 + ks * 4096 + half * 2048; }
__device__ __forceinline__ int crow(int r, int hi) { return (r & 3) + 8 * (r >> 2) + 4 * hi; }
__device__ __forceinline__ unsigned cvtpk(float lo, float hi) {
    unsigned r; asm volatile("v_cvt_pk_bf16_f32 %0, %1, %2" : "=v"(r) : "v"(lo), "v"(hi)); return r;
}
__device__ __forceinline__ bf16x8 pack8(f32x4 a, f32x4 b) {
    u32x4 w = {cvtpk(a[0], a[1]), cvtpk(a[2], a[3]), cvtpk(b[0], b[1]), cvtpk(b[2], b[3])};
    return *reinterpret_cast<bf16x8*>(&w);
}
template <class T> __device__ __forceinline__ bf16x8 load8(const T* p) {
    if constexpr (same_t<T, float>::v) { return pack8(*(const f32x4*)p, *(const f32x4*)(p + 4)); }
    else { return *reinterpret_cast<const bf16x8*>(p); }
}
__device__ __forceinline__ void mask_tile(f32x16& p0, f32x16& p1, int dq, unsigned W) {
    const float NEG = -__builtin_inff();
#pragma unroll
    for (int r = 0; r < 16; ++r) {
        const int c = (r & 3) + 8 * (r >> 2);
        if ((unsigned)(dq - c) >= W) p0[r] = NEG;
        if ((unsigned)(dq - c - 32) >= W) p1[r] = NEG;
    }
}
__device__ __forceinline__ void partialSM(f32x16& p0, f32x16& p1, float& m_reg, float& mn, float& alpha) {
    float pmax = p0[0]; for (int r = 1; r < 16; ++r) pmax = fmaxf(pmax, p0[r]); for (int r = 0; r < 16; ++r) pmax = fmaxf(pmax, p1[r]);
    { auto rr = __builtin_amdgcn_permlane32_swap(__float_as_uint(pmax), __float_as_uint(pmax), false, false);
      pmax = fmaxf(__uint_as_float(rr[0]), __uint_as_float(rr[1])); }
    constexpr float C2 = 1.4426950408889634f * SCALE;
    if (__builtin_expect(__all((pmax - m_reg) * SCALE <= THR), 1)) { mn = m_reg; alpha = 1.f; }
    else { mn = fmaxf(m_reg, pmax); alpha = __builtin_amdgcn_exp2f((m_reg - mn) * C2); m_reg = mn; }
    const float mnL = -mn * C2;
    for (int r = 0; r < 16; ++r) p0[r] = fmaf(p0[r], C2, mnL); for (int r = 0; r < 16; ++r) p1[r] = fmaf(p1[r], C2, mnL);
    for (int r = 0; r < 16; ++r) p0[r] = __builtin_amdgcn_exp2f(p0[r]);
}
__device__ __forceinline__ void finishSM(f32x16& p0, f32x16& p1, float alpha, float& l_reg, bf16x8& pa0, bf16x8& pa1, bf16x8& pa2, bf16x8& pa3) {
    for (int r = 0; r < 16; ++r) p1[r] = __builtin_amdgcn_exp2f(p1[r]);
    float ps = 0; for (int r = 0; r < 16; ++r) ps += p0[r]; for (int r = 0; r < 16; ++r) ps += p1[r];
    { auto rr = __builtin_amdgcn_permlane32_swap(__float_as_uint(ps), __float_as_uint(ps), false, false);
      ps = __uint_as_float(rr[0]) + __uint_as_float(rr[1]); }
    l_reg = l_reg * alpha + ps;
#define PK4(P, B_, OUT) do { unsigned a0 = cvtpk(P[B_+0], P[B_+1]), a1 = cvtpk(P[B_+2], P[B_+3]);                          \
        unsigned b0 = cvtpk(P[B_+4], P[B_+5]), b1 = cvtpk(P[B_+6], P[B_+7]);                                             \
        auto r0 = __builtin_amdgcn_permlane32_swap(a0, b0, false, false); auto r1 = __builtin_amdgcn_permlane32_swap(a1, b1, false, false); \
        u32x4 w = {r0[0], r1[0], r0[1], r1[1]}; OUT = *reinterpret_cast<bf16x8*>(&w); } while (0)
    PK4(p0, 0, pa0); PK4(p0, 8, pa1); PK4(p1, 0, pa2); PK4(p1, 8, pa3);
#undef PK4
}
template <int KB, bool SK>
__device__ __forceinline__ void qkt(f32x16& p0, f32x16& p1, const char* K_lds, int r32, int hi, const bf16x8* qr, bool act) {
    if (SK && !act) { const float NEG = -__builtin_inff();
#pragma unroll
        for (int r = 0; r < 16; ++r) { p0[r] = NEG; p1[r] = NEG; } return; }
    p0 = f32x16{}; p1 = f32x16{};
    const char* kb[4];
#pragma unroll
    for (int dd = 0; dd < 4; ++dd) kb[dd] = K_lds + KB * SHM_K + KSWZ(r32, (dd * 16 + hi * 8) * 2);
#pragma unroll
    for (int d0 = 0; d0 < 8; ++d0) { const char* a = kb[d0 & 3] + (d0 >> 2) * 128;
        bf16x8 b0 = *reinterpret_cast<const bf16x8*>(a);
        bf16x8 b1 = *reinterpret_cast<const bf16x8*>(a + 32 * 256);
        p0 = __builtin_amdgcn_mfma_f32_32x32x16_bf16(b0, qr[d0], p0, 0, 0, 0);
        p1 = __builtin_amdgcn_mfma_f32_32x32x16_bf16(b1, qr[d0], p1, 0, 0, 0); }
}
template <int VB, bool SK>
__device__ __forceinline__ void pv_tile(f32x16* o, int vb0, bf16x8 pa0, bf16x8 pa1, bf16x8 pa2, bf16x8 pa3, bool act) {
    if (SK && !act) return;
#define TRRD(dst, off) asm volatile("ds_read_b64_tr_b16 %0, %1 offset:%2" : "=&v"(dst) : "v"(vb0), "i"(off) : "memory")
#define PV_D0(d0) do { s16x4 l0, l1, l2, l3, h0, h1, h2, h3; constexpr int b_ = VB * SHM_V + v_rd_off(d0, 0, 0);     \
        TRRD(l0, b_); TRRD(h0, b_ + 2048); TRRD(l1, b_ + 4096); TRRD(h1, b_ + 6144); TRRD(l2, b_ + 8192); TRRD(h2, b_ + 10240); TRRD(l3, b_ + 12288); TRRD(h3, b_ + 14336); \
        asm volatile("s_waitcnt lgkmcnt(0)" ::: "memory"); SBAR();                 \
        o[d0] = __builtin_amdgcn_mfma_f32_32x32x16_bf16(pa0, (bf16x8){l0[0], l0[1], l0[2], l0[3], h0[0], h0[1], h0[2], h0[3]}, o[d0], 0, 0, 0);   \
        o[d0] = __builtin_amdgcn_mfma_f32_32x32x16_bf16(pa1, (bf16x8){l1[0], l1[1], l1[2], l1[3], h1[0], h1[1], h1[2], h1[3]}, o[d0], 0, 0, 0);   \
        o[d0] = __builtin_amdgcn_mfma_f32_32x32x16_bf16(pa2, (bf16x8){l2[0], l2[1], l2[2], l2[3], h2[0], h2[1], h2[2], h2[3]}, o[d0], 0, 0, 0);   \
        o[d0] = __builtin_amdgcn_mfma_f32_32x32x16_bf16(pa3, (bf16x8){l3[0], l3[1], l3[2], l3[3], h3[0], h3[1], h3[2], h3[3]}, o[d0], 0, 0, 0); } while (0)
    PV_D0(0); PV_D0(1); PV_D0(2); PV_D0(3);
#undef PV_D0
#undef TRRD
}

template <class TIn, class TOut> struct BlockRef { const TIn* Q; const TIn* K; const TIn* V; float* LSE; int P0; };
template <class TIn> struct Seam {
    bf16x8 qr[8];
    bf16x8 st_v0, st_v1, st_k0, st_k1; f32x4 sf0, sf1, sf2, sf3;
    f32x4 tq[16];
};
__device__ __forceinline__ int swa_jlo(int P0, int W) { const int lowk = P0 - W + 1; return lowk > 0 ? lowk / KVBLK : 0; }
#define ROW(p, k0, rr) ((p) + (size_t)((k0) + (rr)) * D + sc)
#define VMW() asm volatile("s_waitcnt vmcnt(0)" ::: "memory")
#define VMWN(n) asm volatile("s_waitcnt vmcnt(%0)" :: "i"(n) : "memory")
#define SLOAD_H(Kp, Vp, k0) do { S.st_v0 = load8<TIn>(ROW(Vp, k0, sr)); S.st_v1 = load8<TIn>(ROW(Vp, k0, 32 + sr));              \
                         S.st_k0 = load8<TIn>(ROW(Kp, k0, sr)); S.st_k1 = load8<TIn>(ROW(Kp, k0, 32 + sr)); } while (0)
#define SWRITE_HK(bf) do { *(bf16x8*)(K_lds + (bf) * SHM_K + kws) = S.st_k0; *(bf16x8*)(K_lds + (bf) * SHM_K + kws + 32 * 256) = S.st_k1; } while (0)
#define SWRITE_HV(bf) do { *(bf16x8*)(V_lds + (bf) * SHM_V + vst0) = S.st_v0; *(bf16x8*)(V_lds + (bf) * SHM_V + vst1) = S.st_v1; } while (0)
#define SWRITE_H(bf) do { SWRITE_HV(bf); SWRITE_HK(bf); } while (0)
#define SLOAD_F(p, k0) do { S.sf0 = *(const f32x4*)ROW(p, k0, sr); S.sf1 = *(const f32x4*)(ROW(p, k0, sr) + 4);                \
                            S.sf2 = *(const f32x4*)ROW(p, k0, 32 + sr); S.sf3 = *(const f32x4*)(ROW(p, k0, 32 + sr) + 4); } while (0)
#define SWRITE_KF(bf) do { *(bf16x8*)(K_lds + (bf) * SHM_K + kws) = pack8(S.sf0, S.sf1); *(bf16x8*)(K_lds + (bf) * SHM_K + kws + 32 * 256) = pack8(S.sf2, S.sf3); } while (0)
#define SWRITE_VF(bf) do { *(bf16x8*)(V_lds + (bf) * SHM_V + vst0) = pack8(S.sf0, S.sf1); *(bf16x8*)(V_lds + (bf) * SHM_V + vst1) = pack8(S.sf2, S.sf3); } while (0)
template <class TIn, class TOut>
__device__ __forceinline__ void causal_swa_prime(const BlockRef<TIn, TOut>& cur, int W, char* lds, Seam<TIn>& S) {
    constexpr bool F32 = same_t<TIn, float>::v;
    const int tid = threadIdx.x, wid = __builtin_amdgcn_readfirstlane(tid >> 6), lane = tid & 63, r32 = lane & 31, hi = lane >> 5;
    const int sr = tid >> 4, sc = (tid & 15) * 8, kws = KSWZ(sr, sc * 2); char* K_lds = lds + 2 * SHM_V;
    const int kb0 = swa_jlo(cur.P0, W) * KVBLK;
    for (int d0 = 0; d0 < 8; ++d0) S.qr[d0] = load8<TIn>(cur.Q + (size_t)(wid * QBLK + r32) * D + d0 * 16 + hi * 8);
    if constexpr (F32) { SLOAD_F((const float*)cur.K, kb0); VMW(); SWRITE_KF(0); SBAR(); SLOAD_F((const float*)cur.V, kb0); }
    else { SLOAD_H(cur.K, cur.V, kb0); VMW(); SWRITE_HK(0); }
    __syncthreads();
}
template <class TIn, class TOut>
__device__ __forceinline__ void causal_swa_block(const BlockRef<TIn, TOut>& cur, const BlockRef<TIn, TOut>& nxt, int skv, int W, char* lds, Seam<TIn>& S) {
    constexpr bool F32 = same_t<TIn, float>::v;
    const int tid = threadIdx.x, wid = __builtin_amdgcn_readfirstlane(tid >> 6), lane = tid & 63, r32 = lane & 31, hi = lane >> 5;
    const int j_lo = swa_jlo(cur.P0, W);
    int j_hi = (cur.P0 + QB - 1) / KVBLK + 1; if (j_hi > skv / KVBLK) j_hi = skv / KVBLK;
    const int NT = j_hi - j_lo;
    const int kbn = swa_jlo(nxt.P0, W) * KVBLK;
    const int qlo = cur.P0 + wid * QBLK, qm = qlo + r32 - 4 * hi;
    char* V_lds = lds; char* K_lds = lds + 2 * SHM_V;
    float* ws = (float*)(lds + 2 * SHM_V + 2 * SHM_K) + wid * 64; float* li_l = ws, * al_l = ws + 32;
    float m_reg = -1e30f, l_reg = 0; f32x16 o[4] = {};
    const int sr = tid >> 4, sc = (tid & 15) * 8, vst0 = v_st(sr, sc), vst1 = v_st(32 + sr, sc), kws = KSWZ(sr, sc * 2);
    const int vb0 = (int)(uintptr_t)V_lds + v_rd_base(lane);
    const TIn* Kh = cur.K; const TIn* Vh = cur.V;
#define RESC(a) do { if (__any((a) < 1.f)) { if (hi == 0) al_l[r32] = (a); asm volatile("s_waitcnt lgkmcnt(0)" ::: "memory");              \
                     for (int d_ = 0; d_ < 4; ++d_) for (int r = 0; r < 16; ++r) o[d_][r] *= al_l[crow(r, hi)]; } } while (0)
#define KBASE(t) ((j_lo + (t)) * KVBLK)
#define ACT(t) (KBASE(t) <= qlo + QBLK - 1 && KBASE(t) + KVBLK - 1 >= qlo - W + 1)
#define MASKT(P0_, P1_, t) do { const int kb_ = KBASE(t); if ((!SK || ACT(t)) && (kb_ + KVBLK - 1 > qlo || kb_ <= qlo + QBLK - 1 - W)) mask_tile(P0_, P1_, qm - kb_, (unsigned)W); } while (0)
    constexpr int NQL = F32 ? 16 : 8;
    constexpr bool SK = WSKIP && !F32;
#define SEAM_K0() do { VMWN(NQL); if constexpr (F32) { SWRITE_KF(0); SBAR(); SLOAD_F((const float*)nxt.V, kbn); } else { SWRITE_HK(0); } SBAR(); } while (0)
    f32x16 pA0, pA1, pB0, pB1; float mnA, mnB, alA, alB; bf16x8 pa0, pa1, pa2, pa3;
    if constexpr (F32) { VMW(); SWRITE_VF(0); SBAR(); } else { SWRITE_HV(0); SBAR(); }
    if (NT > 1) { if constexpr (F32) SLOAD_F((const float*)Kh, KBASE(1)); else SLOAD_H(Kh, Vh, KBASE(1)); }
    SBAR(); qkt<0, SK>(pA0, pA1, K_lds, r32, hi, S.qr, ACT(0));
    if constexpr (F32) { if (NT > 1) { VMW(); SWRITE_KF(1); SBAR(); SLOAD_F((const float*)Vh, KBASE(1)); } }
    MASKT(pA0, pA1, 0); partialSM(pA0, pA1, m_reg, mnA, alA);
    if (NT > 1) { VMW(); if constexpr (F32) { SWRITE_VF(1); SBAR(); if (NT > 2) SLOAD_F((const float*)Kh, KBASE(2)); } else SWRITE_H(1); }
    __syncthreads();
#define HALF_STEP(PX0, PX1, mnX, alX, PY0, PY1, alY, t, KB, VB, SB) do {                                                      \
        SBAR(); qkt<KB, SK>(PX0, PX1, K_lds, r32, hi, S.qr, ACT(t));                                             \
        finishSM(PY0, PY1, alY, l_reg, pa0, pa1, pa2, pa3); SBAR();                                                           \
        if ((t) + 1 < NT) { if constexpr (F32) { VMW(); SWRITE_KF(SB); SBAR(); SLOAD_F((const float*)Vh, KBASE((t) + 1)); }  \
                            else { SLOAD_H(Kh, Vh, KBASE((t) + 1)); } SBAR(); }                                               \
        pv_tile<VB, SK>(o, vb0, pa0, pa1, pa2, pa3, ACT((t) - 1)); MASKT(PX0, PX1, (t)); partialSM(PX0, PX1, m_reg, mnX, alX);                                        \
        __syncthreads();                                                                                                      \
        if ((t) + 1 < NT) { VMW(); if constexpr (F32) { SWRITE_VF(SB); SBAR(); if ((t) + 2 < NT) SLOAD_F((const float*)Kh, KBASE((t) + 2)); } \
                            else { SWRITE_H(SB); } }                                                                          \
        RESC(alX); __syncthreads(); } while (0)
    for (int t = 1; t + 1 < NT; t += 2) {
        HALF_STEP(pB0, pB1, mnB, alB, pA0, pA1, alA, t, 1, 0, 0);
        HALF_STEP(pA0, pA1, mnA, alA, pB0, pB1, alB, t + 1, 0, 1, 1);
    }
    const bool even = (NT & 1) == 0;
    if (even) { SBAR(); qkt<1, SK>(pB0, pB1, K_lds, r32, hi, S.qr, ACT(NT - 1)); SBAR(); }
#define QROW(e) (nxt.Q + (size_t)(wid * QBLK + r32) * D + ((e) >> 1) * 16 + hi * 8 + ((e) & 1) * 4)
    if constexpr (F32) { SLOAD_F((const float*)nxt.K, kbn); SBAR();
#pragma unroll
        for (int e = 0; e < 8; ++e) S.tq[e] = *(const f32x4*)QROW(e); }
    else { SLOAD_H(nxt.K, nxt.V, kbn); SBAR();
#pragma unroll
        for (int d0 = 0; d0 < 8; ++d0) S.qr[d0] = load8<TIn>(nxt.Q + (size_t)(wid * QBLK + r32) * D + d0 * 16 + hi * 8); }
    SBAR();
    finishSM(pA0, pA1, alA, l_reg, pa0, pa1, pa2, pa3); SBAR();
    if constexpr (F32) {
#pragma unroll
        for (int e = 8; e < 16; ++e) S.tq[e] = *(const f32x4*)QROW(e); SBAR(); }
#undef QROW
    pv_tile<0, SK>(o, vb0, pa0, pa1, pa2, pa3, ACT(even ? NT - 2 : NT - 1));
    if (even) { MASKT(pB0, pB1, NT - 1); partialSM(pB0, pB1, m_reg, mnB, alB); __syncthreads(); RESC(alB);
        finishSM(pB0, pB1, alB, l_reg, pa0, pa1, pa2, pa3); SBAR(); pv_tile<1, SK>(o, vb0, pa0, pa1, pa2, pa3, ACT(NT - 1)); }
    SBAR(); SEAM_K0();
    if (hi == 0) { li_l[r32] = l_reg; cur.LSE[wid * QBLK + r32] = m_reg * SCALE + __logf(l_reg); } asm volatile("s_waitcnt lgkmcnt(0)" ::: "memory");
    float rli[16];
#pragma unroll
    for (int r = 0; r < 16; ++r) rli[r] = __builtin_amdgcn_rcpf(li_l[crow(r, hi)]);
    TOut* Ow = (TOut*)((char*)const_cast<TIn*>(cur.Q) + ATT_O_FROM_Q) + (size_t)(wid * QBLK) * D;
#pragma unroll
    for (int r = 0; r < 16; ++r) { const int orow = crow(r, hi);
#pragma unroll
        for (int d0 = 0; d0 < 4; ++d0) { const float v = o[d0][r] * rli[r];
            if constexpr (same_t<TOut, float>::v) { Ow[(size_t)orow * D + d0 * 32 + r32] = v; }
            else { const float vn = __shfl_xor(v, 1);
                   if ((r32 & 1) == 0) *(unsigned*)(Ow + (size_t)orow * D + d0 * 32 + r32) = cvtpk(v, vn); } } }
    if constexpr (F32) {
#pragma unroll
        for (int d0 = 0; d0 < 8; ++d0) S.qr[d0] = pack8(S.tq[2 * d0], S.tq[2 * d0 + 1]); }
    __syncthreads();
#undef RESC
#undef KBASE
#undef ACT
#undef MASKT
#undef SEAM_K0
#undef HALF_STEP
}
#undef ROW
#undef VMW
#undef VMWN
#undef SLOAD_H
#undef SWRITE_HK
#undef SWRITE_HV
#undef SWRITE_H
#undef SLOAD_F
#undef SWRITE_KF
#undef SWRITE_VF

}
namespace pg8 {
#define PG8_LAS __attribute__((address_space(3)))
typedef unsigned short bf16_t;
typedef short bf16x8 __attribute__((ext_vector_type(8)));
typedef float f32x4 __attribute__((ext_vector_type(4)));
typedef unsigned u32x4 __attribute__((ext_vector_type(4)));
typedef unsigned u32x2 __attribute__((ext_vector_type(2)));
constexpr int BM = 256, BK = 64, HALF = 128, HTB = HALF * BK * 2  , STAGE_BYTES = 8 * HTB, NXCD = 8, WGM = 8;
constexpr int GT_OFF = 140800, GT_UNITS = 18;

__host__ __device__ __forceinline__ int lds_byte(int r, int c) { const int st = (r >> 4) * 2 + (c >> 5), rr = r & 15, cc = c & 31, ob = rr * 64 + cc * 2; return st * 1024 + (ob ^ (((ob >> 9) & 1) << 5)); }
__host__ __device__ __forceinline__ void stage_rc(int b, int& R, int& C) { const int st = b / 1024, sb = b % 1024, swz = sb ^ (((sb >> 9) & 1) << 5); R = (st >> 1) * 16 + swz / 64; C = (st & 1) * 32 + (swz % 64) / 2; }

__device__ __forceinline__ unsigned cvt_pk_bf16(float lo, float hi) { unsigned r; asm volatile("v_cvt_pk_bf16_f32 %0, %1, %2" : "=v"(r) : "v"(lo), "v"(hi)); return r; }

struct GUnit {
    const char* A;
    const char* B;
    const int* rows;
    int nt;
    int pm, pn, aux;
};

template <int WGM_ = WGM>
__device__ __forceinline__ void tile_order(int L, int nM, int nN, int& pm, int& pn) {
    const int nwg = nM * nN; int wgid = L;
    { const int q = nwg / NXCD, r = nwg % NXCD, xcd = wgid % NXCD, off = wgid / NXCD; wgid = (xcd < r ? xcd * (q + 1) : r * (q + 1) + (xcd - r) * q) + off; }
    const int nig = WGM_ * nN, gid = wgid / nig, fm = gid * WGM_, gsz = (nM - fm) < WGM_ ? (nM - fm) : WGM_;
    pm = fm + ((wgid % nig) % gsz); pn = (wgid % nig) / gsz;
}

typedef int i32x8 __attribute__((ext_vector_type(8)));
typedef int i32x4_ __attribute__((ext_vector_type(4)));
template <class Epi, class Sched, bool GATHER, bool FP8 = false>
__device__ __forceinline__ void gemm_phase(PG8_LAS unsigned char* lds, const Sched& S, const Epi& E, const unsigned lda, const unsigned ldb) {
    const int tid = threadIdx.x, wid = __builtin_amdgcn_readfirstlane(tid >> 6), lane = tid & 63, wr = wid >> 2, wc = wid & 3, fr = lane & 15, fq = lane >> 4;
    unsigned voffA0[2], voffA1[2], voffB0[2]; int stR[2], stC[2];
#pragma unroll
    for (int i = 0; i < 2; ++i) { int R, C; stage_rc(tid * 16 + i * 8192, R, C); stR[i] = R; stC[i] = C;
        voffA0[i] = (unsigned)R * lda + (unsigned)C * 2u; voffA1[i] = (unsigned)(R + HALF) * lda + (unsigned)C * 2u;
        voffB0[i] = (unsigned)R * ldb + (unsigned)C * 2u; }
    const size_t kstep = (size_t)(BK * 2);
    const size_t hsA = GATHER ? 0 : (size_t)HALF * lda, hsB = (size_t)HALF * ldb;
    const unsigned ldsw = (unsigned)wid * 1024u;
    const int aoff = FP8 ? lds_byte(wr * 64 + fr, 16 * fq) : lds_byte(wr * 64 + fr, fq * 8), boff = FP8 ? lds_byte(wc * 32 + fr, 16 * fq) : lds_byte(wc * 32 + fr, fq * 8);
#define PG8_SA(b, h) (((b) * 2 + (h)) * HTB)
#define PG8_SB(b, h) ((4 + (b) * 2 + (h)) * HTB)
#define PG8_STAGE(bufoff, gbase, voff) do { _Pragma("unroll") for (int _i = 0; _i < 2; ++_i) \
        __builtin_amdgcn_global_load_lds((const unsigned*)((const char*)(gbase) + (voff)[_i]), (PG8_LAS unsigned*)(lds + (bufoff) + ldsw + _i * 8192), 16, 0, 0); } while (0)
#define PG8_STAGE_A1(bufoff, gbase) do { if constexpr (GATHER) { PG8_STAGE(bufoff, gbase, voffA1); } else { PG8_STAGE(bufoff, (gbase) + hsA, voffA0); } } while (0)
#define PG8_LD16(buf, base, c) (*(const PG8_LAS i32x4_*)(lds + (buf) + (base) + (c)))
#define PG8_LDA(dst, b, h) do { if constexpr (FP8) { _Pragma("unroll") for (int m = 0; m < 4; ++m) dst##8[m] = __builtin_shufflevector(PG8_LD16(PG8_SA(b, h), aoff, m * 2048), PG8_LD16(PG8_SA(b, h), aoff, m * 2048 + 16), 0, 1, 2, 3, 4, 5, 6, 7); } \
      else { _Pragma("unroll") for (int m = 0; m < 4; ++m) _Pragma("unroll") for (int k = 0; k < 2; ++k) dst[m][k] = *(const PG8_LAS bf16x8*)(lds + PG8_SA(b, h) + aoff + m * 2048 + k * 1024); } } while (0)
#define PG8_LDB(dst, b, h) do { if constexpr (FP8) { _Pragma("unroll") for (int n = 0; n < 2; ++n) dst##8[n] = __builtin_shufflevector(PG8_LD16(PG8_SB(b, h), boff, n * 2048), PG8_LD16(PG8_SB(b, h), boff, n * 2048 + 16), 0, 1, 2, 3, 4, 5, 6, 7); } \
      else { _Pragma("unroll") for (int n = 0; n < 2; ++n) _Pragma("unroll") for (int k = 0; k < 2; ++k) dst[n][k] = *(const PG8_LAS bf16x8*)(lds + PG8_SB(b, h) + boff + n * 2048 + k * 1024); } } while (0)
#define PG8_MMA(ai, bj, At, Bt) do { __builtin_amdgcn_s_setprio(1); if constexpr (FP8) { _Pragma("unroll") for (int m = 0; m < 4; ++m) _Pragma("unroll") for (int n = 0; n < 2; ++n) \
        asm volatile("v_mfma_scale_f32_16x16x128_f8f6f4 %0, %1, %2, %0, %3, %3 op_sel_hi:[0,0,0]" : "+v"(acc[ai][bj][m][n]) : "v"(Bt##8[n]), "v"(At##8[m]), "v"(sc8)); } \
      else { _Pragma("unroll") for (int m = 0; m < 4; ++m) _Pragma("unroll") for (int n = 0; n < 2; ++n) _Pragma("unroll") for (int k = 0; k < 2; ++k) \
        acc[ai][bj][m][n] = __builtin_amdgcn_mfma_f32_16x16x32_bf16(Bt[n][k], At[m][k], acc[ai][bj][m][n], 0, 0, 0); } __builtin_amdgcn_s_setprio(0); } while (0)
#define PG8_WAIT_V(n) asm volatile("s_waitcnt vmcnt(" #n ")" ::: "memory")
#define PG8_WAIT_L(n) asm volatile("s_waitcnt lgkmcnt(" #n ")" ::: "memory")
#define PG8_BAR __builtin_amdgcn_s_barrier()
#define PG8_SCHED __builtin_amdgcn_sched_barrier(0)
#define PG8_GATHER_OFFS(uidx) do { if constexpr (GATHER) { const PG8_LAS int* gr_ = gtab + (uidx) * 256; _Pragma("unroll") for (int _i = 0; _i < 2; ++_i) { \
        const unsigned r0_ = (unsigned)gr_[stR[_i]], r1_ = (unsigned)gr_[stR[_i] + HALF]; \
        voffA0[_i] = r0_ * lda + (unsigned)stC[_i] * 2u; voffA1[_i] = r1_ * lda + (unsigned)stC[_i] * 2u; } } } while (0)
    GUnit cur, nxt; int ui = 0;
    PG8_LAS int* gtab = (PG8_LAS int*)(lds + GT_OFF);
    if constexpr (GATHER) {
        int rv[GT_UNITS / 2];
#pragma unroll
        for (int j = 0; j < GT_UNITS / 2; ++j) { GUnit uu; rv[j] = S.next(2 * j + (tid >> 8), uu) ? ((const __attribute__((address_space(1))) int*)uu.rows)[tid & 255] : 0; }
#pragma unroll
        for (int j = 0; j < GT_UNITS / 2; ++j) gtab[(2 * j + (tid >> 8)) * 256 + (tid & 255)] = rv[j];
        __syncthreads();
    }
    if (!S.next(0, cur)) return;
    f32x4 acc[2][2][4][2];
#pragma unroll
    for (int a = 0; a < 2; ++a)
#pragma unroll
        for (int b = 0; b < 2; ++b)
#pragma unroll
            for (int m = 0; m < 4; ++m)
#pragma unroll
                for (int n = 0; n < 2; ++n) acc[a][b][m][n] = (f32x4){0.f, 0.f, 0.f, 0.f};
    bf16x8 At[4][2], B0[2][2], B1[2][2]; i32x8 At8[4], B08[2], B18[2];
    int sc8 = 0x7F7F7F7F; asm volatile("" : "+v"(sc8));
    const char* cA = cur.A; const char* cB = cur.B;
    PG8_GATHER_OFFS(0);
    PG8_STAGE(PG8_SB(0, 0), cB, voffB0); PG8_STAGE(PG8_SB(0, 1), (cB) + hsB, voffB0); PG8_STAGE(PG8_SA(0, 0), cA, voffA0); PG8_STAGE_A1(PG8_SA(0, 1), cA);
    if (wr == 1) PG8_BAR;
    PG8_WAIT_V(2); PG8_BAR;
    PG8_STAGE(PG8_SB(1, 0), cB + kstep, voffB0); PG8_STAGE(PG8_SA(1, 0), cA + kstep, voffA0); PG8_STAGE(PG8_SB(1, 1), (cB + kstep) + hsB, voffB0);
    PG8_WAIT_V(6); PG8_BAR;
    for (;;) {
        const bool has_next = S.next(ui + 1, nxt);
        if (!has_next) { nxt = cur; }
        const char* nA = nxt.A; const char* nB = nxt.B;
        const int nt = cur.nt;
        for (int t = 0; t < nt; t += 2) {
            const bool last = (t == nt - 2);
            asm volatile("" : "+v"(voffA0[0]), "+v"(voffA0[1]), "+v"(voffB0[0]), "+v"(voffB0[1]));
            if constexpr (GATHER) asm volatile("" : "+v"(voffA1[0]), "+v"(voffA1[1]));
            const char* a1 = cA + (size_t)(t + 1) * kstep;
            const char* a2 = last ? nA : cA + (size_t)(t + 2) * kstep; const char* b2 = last ? nB : cB + (size_t)(t + 2) * kstep;
            const char* a3 = a2 + kstep; const char* b3 = b2 + kstep;
            PG8_LDB(B0, 0, 0); PG8_LDB(B1, 0, 1); PG8_SCHED; PG8_LDA(At, 0, 0); PG8_STAGE_A1(PG8_SA(1, 1), a1);
            PG8_WAIT_V(8); PG8_WAIT_L(0); PG8_BAR; PG8_MMA(0, 0, At, B0); PG8_MMA(0, 1, At, B1); PG8_BAR; PG8_SCHED;
            if constexpr (GATHER) { if (last) { const int un_ = has_next ? (ui + 1 < GT_UNITS ? ui + 1 : GT_UNITS - 1) : ui; PG8_GATHER_OFFS(un_); } }
            PG8_LDA(At, 0, 1); PG8_STAGE(PG8_SB(0, 0), b2, voffB0); PG8_STAGE(PG8_SB(0, 1), (b2) + hsB, voffB0); PG8_STAGE(PG8_SA(0, 0), a2, voffA0);
            PG8_WAIT_V(8); PG8_WAIT_L(0); PG8_BAR; PG8_MMA(1, 0, At, B0); PG8_MMA(1, 1, At, B1); PG8_BAR; PG8_SCHED;
            PG8_LDB(B0, 1, 0); PG8_LDB(B1, 1, 1); PG8_SCHED; PG8_LDA(At, 1, 0); PG8_STAGE_A1(PG8_SA(0, 1), a2);
            PG8_WAIT_V(8); PG8_WAIT_L(0); PG8_BAR; PG8_MMA(0, 0, At, B0); PG8_MMA(0, 1, At, B1); PG8_BAR; PG8_SCHED;
            PG8_LDA(At, 1, 1); PG8_STAGE(PG8_SB(1, 0), b3, voffB0); PG8_STAGE(PG8_SB(1, 1), (b3) + hsB, voffB0); PG8_STAGE(PG8_SA(1, 0), a3, voffA0);
            PG8_WAIT_V(8); PG8_WAIT_L(0); PG8_BAR; PG8_MMA(1, 0, At, B0); PG8_MMA(1, 1, At, B1); PG8_BAR; PG8_SCHED;
        }
        if (wr == 0) PG8_BAR;
        if constexpr (FP8) asm volatile("s_nop 15\n\ts_nop 15" ::: "memory");
        int tz = threadIdx.x; asm volatile("" : "+v"(tz));
        const int wz = __builtin_amdgcn_readfirstlane(tz >> 6);
        const bool keep = E(acc, cur, wz >> 2, wz & 3, tz & 15, (tz & 63) >> 4);
        if (!has_next) break;
        if (!keep) {
#pragma unroll
            for (int a = 0; a < 2; ++a)
#pragma unroll
                for (int b = 0; b < 2; ++b)
#pragma unroll
                    for (int m = 0; m < 4; ++m)
#pragma unroll
                        for (int n = 0; n < 2; ++n) acc[a][b][m][n] = (f32x4){0.f, 0.f, 0.f, 0.f};
        }
        cur = nxt; cA = nA; cB = nB; ++ui;
        if (wr == 1) PG8_BAR;
    }
    PG8_WAIT_V(0);
    PG8_BAR;
#undef PG8_SA
#undef PG8_SB
#undef PG8_STAGE
#undef PG8_STAGE_A1
#undef PG8_LDA
#undef PG8_LDB
#undef PG8_MMA
#undef PG8_LD16
#undef PG8_WAIT_V
#undef PG8_WAIT_L
#undef PG8_BAR
#undef PG8_SCHED
#undef PG8_GATHER_OFFS
}
}
struct Args {
    const float* x; const int* pos; const float* g_mix; const float* w_in; const float* w_gk_up; const float* b_gk; const float* g_gla;
    const float* w_oa; const float* w_ob; const float* w_out; const float* g_ffn; const float* w_router; const float* b_router;
    const float* w_mlp1; const float* b_mlp1; const float* w_mlp2; const float* b_mlp2; const float* g_final;
    float* out; unsigned char* ws; int ph_lo, ph_hi;
};

__device__ __forceinline__ int perm_c(int s) { return (s & 128) + (s & 96) + 8 * ((s >> 2) & 3) + 4 * ((s >> 4) & 1) + (s & 3); }
__device__ __forceinline__ int perm_y(int s) { return 64 * ((s >> 5) & 3) + 16 * ((s >> 2) & 3) + 8 * (s >> 7) + 4 * ((s >> 4) & 1) + (s & 3); }
__device__ __forceinline__ int rope_d(int s) { return 64 * ((s >> 4) & 1) + 16 * ((s >> 5) & 3) + 4 * ((s >> 2) & 3) + (s & 3); }
__device__ __forceinline__ int win_src(int pn, int s) {
    if (pn < 9)  return C_QA + pn * 256 + (s & 128) + rope_d(s);
    if (pn < 18) return C_KA + (pn - 9) * 256 + (s & 128) + rope_d(s);
    if (pn < 27) return C_VA + (pn - 18) * 256 + perm_c(s);
    if (pn < 31) return C_QB + (pn - 27) * 256 + perm_c(s);
    if (pn < 35) return C_KB + (pn - 31) * 256 + perm_c(s);
    if (pn < 43) return C_VB + (pn - 35) * 256 + perm_c(s);
    if (pn < 51) return C_GB + (pn - 43) * 256 + perm_c(s);
    if (pn < 67) return ((s & 128) ? C_GBT : C_GA) + (pn - 51) * 128 + (perm_c(s) & 127);
    return s < 16 ? C_GKL + s : -1;
}

#ifndef F8_GROUPS
#define F8_GROUPS 0x31
#endif
constexpr int grp_start(int g) { return g == 0 ? 0 : g == 1 ? 27 : g == 2 ? 35 : g == 3 ? 43 : g == 4 ? 51 : 67; }
constexpr int grp_size(int g) { return g == 0 ? 27 : g == 4 ? 16 : g == 5 ? 1 : 8; }
constexpr int grp_count(unsigned mask) { int n = 0; for (int g = 0; g < 6; ++g) if ((mask >> g) & 1) n += grp_size(g); return n; }
constexpr int NT8 = grp_count(F8_GROUPS), NT16 = 68 - NT8;
__device__ __forceinline__ int pn_of(int j, unsigned mask) {
#pragma unroll
    for (int g = 0; g < 6; ++g) if ((mask >> g) & 1) { if (j < grp_size(g)) return grp_start(g) + j; j -= grp_size(g); }
    return 67;
}
__device__ __forceinline__ int pn_of8(int j) { return pn_of(j, F8_GROUPS); }
__device__ __forceinline__ int pn_of16(int j) { return pn_of(j, 0x3F & ~(F8_GROUPS)); }
constexpr float H8_SCALE = 16.0f;
__device__ __forceinline__ void cvt_item(const float* W, int ldw, bf16_t* Bt, int ldbt, int koff, int tile, int kb, int map, LAS unsigned* scr, int tid) {
    const int k0 = kb * 64;
#pragma unroll
    for (int rep = 0; rep < 4; ++rep) {
        const int q = tid + 512 * rep, kp = q >> 6, s = (q & 63) * 4;
        int col;
        if (map == 0) col = tile * 256 + s;
        else if (map == 1) col = tile * 256 + perm_c(s);
        else if (map == 2) col = win_src(tile, s);
        else col = ((s & 128) ? 2048 : 0) + tile * 128 + (perm_c(s) & 127);
        f32x4 a = {0.f, 0.f, 0.f, 0.f}, b = {0.f, 0.f, 0.f, 0.f};
        if (col >= 0) { const GAS float* p = (const GAS float*)W + (size_t)(k0 + 2 * kp) * ldw + col; a = __builtin_nontemporal_load((const GAS f32x4*)p); b = __builtin_nontemporal_load((const GAS f32x4*)(p + ldw)); }
        scr[(s + 0) * 33 + kp] = cvtpk(a[0], b[0]); scr[(s + 1) * 33 + kp] = cvtpk(a[1], b[1]);
        scr[(s + 2) * 33 + kp] = cvtpk(a[2], b[2]); scr[(s + 3) * 33 + kp] = cvtpk(a[3], b[3]);
    }
    __syncthreads();
#pragma unroll
    for (int rep = 0; rep < 4; ++rep) {
        const int q = tid + 512 * rep, s = q >> 3, seg = q & 7;
        const LAS unsigned* r = scr + s * 33 + seg * 4;
        u32x4 o = {r[0], r[1], r[2], r[3]};
        *(GAS u32x4*)(Bt + (size_t)(tile * 256 + s) * ldbt + koff + k0 + seg * 8) = o;
    }
    __syncthreads();
}

#ifndef MOE_FP8
#define MOE_FP8 1
#endif
constexpr float W8_SCALE = 64.0f, W8_INV = 1.0f / 64.0f;
__device__ __forceinline__ unsigned pk4_fp8(float a, float b, float c, float d) {
    int r = __builtin_amdgcn_cvt_pk_fp8_f32(a, b, 0, false);
    r = __builtin_amdgcn_cvt_pk_fp8_f32(c, d, r, true);
    return (unsigned)r;
}
__device__ __forceinline__ float clamp8(float x) { return fminf(fmaxf(x, -448.f), 448.f); }
__device__ __forceinline__ void cvt_item8(const float* W, int ldw, unsigned char* Bt, int ldbt, int tile, int kb, int map, LAS unsigned* scr, int tid, int srct = 0, int koff = 0) {
    const int k0 = kb * 128;
#pragma unroll
    for (int rep = 0; rep < 4; ++rep) {
        const int q = tid + 512 * rep, kq = q >> 6, s = (q & 63) * 4;
        const int col = (map == 1) ? tile * 256 + perm_c(s) : (map == 2) ? win_src(srct, s) : ((s & 128) ? 2048 : 0) + tile * 128 + (perm_c(s) & 127);
        const GAS float* p = (const GAS float*)W + (size_t)(k0 + 4 * kq) * ldw + (col < 0 ? 0 : col);
        const float wsc = col < 0 ? 0.f : W8_SCALE;
        const f32x4 a0 = __builtin_nontemporal_load((const GAS f32x4*)p) * wsc, a1 = __builtin_nontemporal_load((const GAS f32x4*)(p + ldw)) * wsc, a2 = __builtin_nontemporal_load((const GAS f32x4*)(p + 2 * (size_t)ldw)) * wsc, a3 = __builtin_nontemporal_load((const GAS f32x4*)(p + 3 * (size_t)ldw)) * wsc;
        scr[(s + 0) * 33 + kq] = pk4_fp8(a0[0], a1[0], a2[0], a3[0]); scr[(s + 1) * 33 + kq] = pk4_fp8(a0[1], a1[1], a2[1], a3[1]);
        scr[(s + 2) * 33 + kq] = pk4_fp8(a0[2], a1[2], a2[2], a3[2]); scr[(s + 3) * 33 + kq] = pk4_fp8(a0[3], a1[3], a2[3], a3[3]);
    }
    __syncthreads();
#pragma unroll
    for (int rep = 0; rep < 4; ++rep) {
        const int q = tid + 512 * rep, s = q >> 3, seg = q & 7;
        const LAS unsigned* r = scr + s * 33 + seg * 4;
        u32x4 o = {r[0], r[1], r[2], r[3]};
        *(GAS u32x4*)(Bt + (size_t)(tile * 256 + s) * ldbt + koff + k0 + seg * 16) = o;
    }
    __syncthreads();
}

#ifndef MERGE_FP8
#define MERGE_FP8 1
#endif
constexpr float O8_SCALE = 8.0f;
#ifndef CVT_SPLIT
#define CVT_SPLIT 0
#endif
#ifndef NCVT
#define NCVT 40
#endif
struct Cvt8Item { const GAS float* src; unsigned char* dst; int ldw; };
__device__ __forceinline__ void cvt8_decode(const Args& a, int it, int tid, Cvt8Item& X, int rep_col[4]) {
    constexpr int I4 = 32 * 16 * 16;
    const float* W; int ldw, tile, kb, map; unsigned char* Bt;
    if (it < I4) { const int e = it / 256, q = it % 256; W = a.w_mlp1 + (size_t)e * DM * 4096; ldw = 4096; Bt = a.ws + WS_W1 + (size_t)e * 4096 * DM; tile = q / 16; kb = q % 16; map = 3; }
    else { const int r = it - I4, e = r / 128, q = r % 128; W = a.w_mlp2 + (size_t)e * DM * DM; ldw = DM; Bt = a.ws + WS_W2 + (size_t)e * DM * DM; tile = q / 16; kb = q % 16; map = 1; }
    X.ldw = ldw; X.dst = Bt + (size_t)tile * 256 * DM + kb * 128;
    const int s = (tid & 63) * 4;
    const int col = (map == 1) ? tile * 256 + perm_y(s) : ((s & 128) ? 2048 : 0) + tile * 128 + (perm_c(s) & 127);
    X.src = (const GAS float*)W + (size_t)(kb * 128 + 4 * (tid >> 6)) * ldw + col;
    (void)rep_col;
}
__device__ __forceinline__ void cvt8_issue(const Cvt8Item& X, f32x4 (&v)[16]) {
#pragma unroll
    for (int rep = 0; rep < 4; ++rep)
#pragma unroll
        for (int k = 0; k < 4; ++k) v[rep * 4 + k] = __builtin_nontemporal_load((const GAS f32x4*)(X.src + (size_t)(32 * rep + k) * X.ldw));
}
__device__ __forceinline__ void cvt8_finish(const Cvt8Item& X, const f32x4 (&v)[16], LAS unsigned* scr, int tid) {
    const int s = (tid & 63) * 4;
#pragma unroll
    for (int rep = 0; rep < 4; ++rep) {
        const int kq = (tid >> 6) + 8 * rep;
        const f32x4 a0 = v[rep * 4] * W8_SCALE, a1 = v[rep * 4 + 1] * W8_SCALE, a2 = v[rep * 4 + 2] * W8_SCALE, a3 = v[rep * 4 + 3] * W8_SCALE;
        scr[(s + 0) * 33 + kq] = pk4_fp8(a0[0], a1[0], a2[0], a3[0]); scr[(s + 1) * 33 + kq] = pk4_fp8(a0[1], a1[1], a2[1], a3[1]);
        scr[(s + 2) * 33 + kq] = pk4_fp8(a0[2], a1[2], a2[2], a3[2]); scr[(s + 3) * 33 + kq] = pk4_fp8(a0[3], a1[3], a2[3], a3[3]);
    }
    __syncthreads();
#pragma unroll
    for (int rep = 0; rep < 4; ++rep) {
        const int q = tid + 512 * rep, sl = q >> 3, seg = q & 7;
        const LAS unsigned* r = scr + sl * 33 + seg * 4;
        u32x4 o = {r[0], r[1], r[2], r[3]};
        __builtin_nontemporal_store(o, (GAS u32x4*)(X.dst + (size_t)sl * DM + seg * 16));
    }
    __syncthreads();
}
__device__ __forceinline__ void phase_cvt_experts(const Args& a, LAS unsigned char* lds, int first, int stride) {
    const int tid = threadIdx.x;
    LAS unsigned* scr = (LAS unsigned*)lds;
    constexpr int NI = 32 * 16 * 16 + 32 * 8 * 16;
    int it = first; if (it >= NI) return;
    Cvt8Item XA, XB; f32x4 vA[16], vB[16]; int dummy[4];
    cvt8_decode(a, it, tid, XA, dummy); cvt8_issue(XA, vA);
    for (;;) {
        const int itB = it + stride; const bool hasB = itB < NI;
        if (hasB) { cvt8_decode(a, itB, tid, XB, dummy); cvt8_issue(XB, vB); }
        cvt8_finish(XA, vA, scr, tid);
        if (!hasB) break;
        const int itA = itB + stride; const bool hasA = itA < NI;
        if (hasA) { cvt8_decode(a, itA, tid, XA, dummy); cvt8_issue(XA, vA); }
        cvt8_finish(XB, vB, scr, tid);
        if (!hasA) break;
        it = itA;
    }
}

__device__ __forceinline__ void phase_prologue(const Args& a, LAS unsigned char* lds, int vcu, int G) {
    const int tid = threadIdx.x, lane = tid & 63, wave = tid >> 6;
    LAS unsigned* scr = (LAS unsigned*)lds;
    unsigned char* ws = a.ws;
#if MOE_FP8
    constexpr int I0 = NT16 * 32, I1 = MERGE_FP8 ? 8 * 6 : 8 * 12, I2 = MERGE_FP8 ? 8 * 16 : 8 * 32, I3 = 8 * 32, I0b = NT8 * 16, I4 = 32 * 16 * 16, I5 = 32 * 8 * 16;
#else
    constexpr int I0 = 68 * 32, I1 = 8 * 12, I2 = 8 * 32, I3 = 8 * 32, I4 = 32 * 16 * 32, I5 = 32 * 8 * 32;
#endif
    for (int it = vcu; it < I0 + I0b + I1 + I2 + I3; it += G) {
        int r = it;
        if (r < I0) { cvt_item(a.w_in, IN_W, (bf16_t*)(ws + WS_WIN), DM, 0, pn_of16(r / 32), r % 32, 2, scr, tid); continue; } r -= I0;
        if (r < I0b) { cvt_item8(a.w_in, IN_W, ws + WS_WIN8, DM, r / 16, r % 16, 2, scr, tid, pn_of8(r / 16)); continue; } r -= I0b;
#if MERGE_FP8
        if (r < I1) { cvt_item8(a.w_oa, DM, ws + WS_WM, KCAT, r / 6, r % 6, 1, scr, tid, 0, 0); continue; } r -= I1;
        if (r < I2) { cvt_item8(a.w_ob, DM, ws + WS_WM, KCAT, r / 16, r % 16, 1, scr, tid, 0, ATT_OUT); continue; } r -= I2;
#else
        if (r < I1) { cvt_item(a.w_oa, DM, (bf16_t*)(ws + WS_WM), KCAT, 0, r / 12, r % 12, 1, scr, tid); continue; } r -= I1;
        if (r < I2) { cvt_item(a.w_ob, DM, (bf16_t*)(ws + WS_WM), KCAT, ATT_OUT, r / 32, r % 32, 1, scr, tid); continue; } r -= I2;
#endif
        cvt_item(a.w_out, DM, (bf16_t*)(ws + WS_WO), DM, 0, r / 32, r % 32, 0, scr, tid);
    }
#if !CVT_SPLIT
    phase_cvt_experts(a, lds, vcu, G);
#endif
    const int gw = vcu * NWAVES + wave, NGW = G * NWAVES;
    for (int m = gw; m < T; m += NGW) {
        const GAS f32x4* xr = (const GAS f32x4*)(a.x + (size_t)m * DM) + lane;
        f32x4 v[8]; float s = 0.f;
#pragma unroll
        for (int j = 0; j < 8; ++j) { v[j] = xr[64 * j]; s += (v[j][0] * v[j][0] + v[j][1] * v[j][1]) + (v[j][2] * v[j][2] + v[j][3] * v[j][3]); }
        const float rstd = rsqrtf(wave_sum(s) * (1.f / DM) + NORM_EPS);
        GAS u32x2* o = (GAS u32x2*)((bf16_t*)(ws + WS_H) + (size_t)m * DM) + lane;
        GAS unsigned* o8 = (GAS unsigned*)(ws + WS_H8 + (size_t)m * DM) + lane;
#pragma unroll
        for (int j = 0; j < 8; ++j) { const f32x4 g = *((const GAS f32x4*)a.g_mix + lane + 64 * j);
            const f32x4 hv = {v[j][0] * rstd * g[0], v[j][1] * rstd * g[1], v[j][2] * rstd * g[2], v[j][3] * rstd * g[3]};
            u32x2 w; w.x = cvtpk(hv[0], hv[1]); w.y = cvtpk(hv[2], hv[3]); o[64 * j] = w;
            o8[64 * j] = pk4_fp8(clamp8(hv[0] * H8_SCALE), clamp8(hv[1] * H8_SCALE), clamp8(hv[2] * H8_SCALE), clamp8(hv[3] * H8_SCALE)); }
    }
    for (int i = vcu * 512 + tid; i < T * 64; i += G * 512) {
        const int t = i >> 6, f = i & 63;
        const float inv = (float)pow(10000.0, -(double)f / 64.0);
        const float ang = (float)a.pos[t] * inv;
        float sn, cs; sincosf(ang, &sn, &cs);
        ((float*)(ws + WS_COS))[i] = cs; ((float*)(ws + WS_SIN))[i] = sn;
    }
    for (int i = vcu * 512 + tid; i < NE * DM; i += G * 512) {
        const int e = i / DM, k = i % DM;
        const float w = a.w_router[(size_t)k * NE + e] * a.g_ffn[k];
        const unsigned hi = cvtpk(w, 0.f) & 0xffffu; const float lo = w - __uint_as_float(hi << 16);
        ((bf16_t*)(ws + WS_WRH))[i] = (bf16_t)hi; ((bf16_t*)(ws + WS_WRL))[i] = (bf16_t)(cvtpk(lo, 0.f) & 0xffffu);
    }
}

struct DenseSched {
    const char* A; const char* B; int nM, nN, nt, G, c; size_t tsA, tsB;
    __device__ __forceinline__ bool next(int i, pg8::GUnit& u) const {
        const long L = (long)i * G + c; if (L >= (long)nM * nN) return false;
        pg8::tile_order((int)L, nM, nN, u.pm, u.pn);
        u.A = A + (size_t)u.pm * tsA; u.B = B + (size_t)u.pn * tsB; u.nt = nt; u.aux = 0; u.rows = nullptr; return true;
    }
};
struct InProjSched {
    const char* A; const char* B; int nM, nN, nt, G, c; size_t tsA, tsB; bool f8;
    __device__ __forceinline__ bool next(int i, pg8::GUnit& u) const {
        const long L = (long)i * G + c; if (L >= (long)nM * nN) return false;
        int j; pg8::tile_order((int)L, nM, nN, u.pm, j);
        u.pn = f8 ? pn_of8(j) : pn_of16(j);
        u.A = A + (size_t)u.pm * tsA; u.B = B + (size_t)(f8 ? j : u.pn) * tsB; u.nt = nt; u.aux = 0; u.rows = nullptr; return true;
    }
};
struct MergeSched {
    const char* A; const char* B; int nM, nN, G, c; size_t tsA, tsB;
    __device__ __forceinline__ bool next(int i, pg8::GUnit& u) const {
        const long L = (long)(i >> 1) * G + c; if (L >= (long)nM * nN) return false;
        pg8::tile_order((int)L, nM, nN, u.pm, u.pn);
        const int part = i & 1;
        constexpr int EB = MERGE_FP8 ? 1 : 2;
        u.A = A + (size_t)u.pm * tsA + (part ? ATT_OUT * EB : 0); u.B = B + (size_t)u.pn * tsB + (part ? ATT_OUT * EB : 0);
        u.nt = (part ? 32 : 12) / (MERGE_FP8 ? 2 : 1); u.aux = part; u.rows = nullptr; return true;
    }
};
#ifndef WGM_MOE
#define WGM_MOE 8
#endif
struct MoeSched {
    const char* A; const char* B; const LAS int* tl; const int* tok; int nN, G, c; size_t tsA, tsB, esB; bool gather; int nt;
    __device__ __forceinline__ bool next(int i, pg8::GUnit& u) const {
        const int nM = __builtin_amdgcn_readfirstlane(tl[0]);
        const long L = (long)i * G + c; if (L >= (long)nM * nN) return false;
        pg8::tile_order<WGM_MOE>((int)L, nM, nN, u.pm, u.pn);
        const int e = __builtin_amdgcn_readfirstlane(tl[16 + u.pm]);
        u.A = gather ? A : A + (size_t)u.pm * tsA; u.B = B + (size_t)e * esB + (size_t)u.pn * tsB; u.nt = nt; u.aux = e; u.rows = tok + u.pm * 256; return true;
    }
};
constexpr int TL_OFF = 139520;
__device__ __forceinline__ const LAS int* load_tile_table(LAS unsigned char* lds, const unsigned char* ws) {
    LAS int* tl = (LAS int*)(lds + TL_OFF);
    if (threadIdx.x < 304) tl[threadIdx.x] = ((const GAS int*)(ws + WS_TILEE))[threadIdx.x];
    __syncthreads();
    return tl;
}

typedef pg8::f32x4 (&AccRef)[2][2][4][2];
__device__ __forceinline__ u32x4 pack8(const f32x4 a, const f32x4 b) { u32x4 w = {cvtpk(a[0], a[1]), cvtpk(a[2], a[3]), cvtpk(b[0], b[1]), cvtpk(b[2], b[3])}; return w; }

template <bool F8>
struct EpiInProj {
    unsigned char* ws; int dry;
    __device__ __forceinline__ void st16(bf16_t* p, const u32x4 v) const {
        if (dry == 2) { asm volatile("" :: "v"(v[0]), "v"(v[1]), "v"(v[2]), "v"(v[3])); }
        else if (dry == 3) { *(GAS u32x4*)(ws + WS_Y + (size_t)blockIdx.x * 8192 + threadIdx.x * 16) = v; }
        else {
#if defined(EPI_STORE_SC1)
            asm volatile("global_store_dwordx4 %0, %1, off sc1\n\ts_nop 1" :: "v"((GAS u32x4*)p), "v"(v) : "memory");
#elif defined(EPI_STORE_SC01)
            asm volatile("global_store_dwordx4 %0, %1, off sc0 sc1\n\ts_nop 1" :: "v"((GAS u32x4*)p), "v"(v) : "memory");
#else
            *(GAS u32x4*)p = v;
#endif
        }
    }
    __device__ __forceinline__ bool operator()(AccRef acc, const pg8::GUnit& u, int wr, int wc, int fr, int fq) const {
        if (dry == 1) { float sx = 0.f;
#pragma unroll
            for (int ai = 0; ai < 2; ++ai)
#pragma unroll
                for (int bj = 0; bj < 2; ++bj)
#pragma unroll
                    for (int m = 0; m < 4; ++m)
#pragma unroll
                        for (int n = 0; n < 2; ++n) sx += (acc[ai][bj][m][n][0] + acc[ai][bj][m][n][1]) + (acc[ai][bj][m][n][2] + acc[ai][bj][m][n][3]);
            if (sx == 1234.56789f) ((GAS float*)(ws + WS_Y))[threadIdx.x] = sx;
            return false; }
        if constexpr (F8) {
#pragma unroll
            for (int ai = 0; ai < 2; ++ai)
#pragma unroll
                for (int bj = 0; bj < 2; ++bj)
#pragma unroll
                    for (int m = 0; m < 4; ++m)
#pragma unroll
                        for (int n = 0; n < 2; ++n) acc[ai][bj][m][n] *= (1.0f / (H8_SCALE * W8_SCALE));
        }
        const int pn = u.pn, row0 = u.pm * 256 + wr * 64 + fr;
        if (pn < 27) {
            const bool rope = pn < 18; const int hp = pn < 9 ? pn : (pn < 18 ? pn - 9 : pn - 18);
            bf16_t* dst = (bf16_t*)(ws + (pn < 9 ? WS_QA : (pn < 18 ? WS_KA : WS_VA)));
#pragma unroll
            for (int ai = 0; ai < 2; ++ai)
#pragma unroll
                for (int m = 0; m < 4; ++m) {
                    const int t = row0 + ai * 128 + m * 16, b = t >> 12, tt = t & 4095;
                    f32x4 cs = {1.f, 1.f, 1.f, 1.f}, sn = {0.f, 0.f, 0.f, 0.f};
                    if (rope) { cs = *(const GAS f32x4*)((const float*)(ws + WS_COS) + (size_t)t * 64 + 16 * wc + 4 * fq); sn = *(const GAS f32x4*)((const float*)(ws + WS_SIN) + (size_t)t * 64 + 16 * wc + 4 * fq); }
#pragma unroll
                    for (int bj = 0; bj < 2; ++bj) {
                        const int H = 2 * hp + bj, g = H / 6, hh = H - 6 * g, sh = 2 * g, L = 4096 >> sh;
                        const int ridx = (tt & ((1 << sh) - 1)) * L + (tt >> sh);
                        const f32x4 x1 = acc[ai][bj][m][0], x2 = acc[ai][bj][m][1];
                        f32x4 o1, o2;
                        if (rope) { o1 = x1 * cs - x2 * sn; o2 = x2 * cs + x1 * sn; } else { o1 = x1; o2 = x2; }
                        st16(dst + ((size_t)((g * 4 + b) * 6 + hh) * 4096 + ridx) * 128 + 32 * wc + 8 * fq, pack8(o1, o2));
                    }
                }
        } else if (pn < 51) {
            bf16_t* dst; int ld, cb;
            if (pn < 31) { dst = (bf16_t*)(ws + WS_QB); ld = GLA_K; cb = (pn - 27) * 256; }
            else if (pn < 35) { dst = (bf16_t*)(ws + WS_KB); ld = GLA_K; cb = (pn - 31) * 256; }
            else if (pn < 43) { dst = (bf16_t*)(ws + WS_VB); ld = GLA_V; cb = (pn - 35) * 256; }
            else { dst = (bf16_t*)(ws + WS_GB); ld = GLA_V; cb = (pn - 43) * 256; }
#pragma unroll
            for (int ai = 0; ai < 2; ++ai)
#pragma unroll
                for (int m = 0; m < 4; ++m) {
                    bf16_t* rp = dst + (size_t)(row0 + ai * 128 + m * 16) * ld + cb + 32 * wc + 8 * fq;
#pragma unroll
                    for (int bj = 0; bj < 2; ++bj) st16(rp + 128 * bj, pack8(acc[ai][bj][m][0], acc[ai][bj][m][1]));
                }
        } else if (pn < 67) {
            const int cb = (pn - 51) * 128 + 32 * wc + 8 * fq;
#pragma unroll
            for (int ai = 0; ai < 2; ++ai)
#pragma unroll
                for (int m = 0; m < 4; ++m) {
                    f32x4 r[2], s[2];
#pragma unroll
                    for (int n = 0; n < 2; ++n)
#pragma unroll
                        for (int j = 0; j < 4; ++j) { const float ea = __expf(-acc[ai][0][m][n][j]), eb = __expf(-acc[ai][1][m][n][j]);
                            s[n][j] = __builtin_amdgcn_rcpf(1.0f + eb); r[n][j] = fminf((1.0f + eb) * __builtin_amdgcn_rcpf(1.0f + ea), 1e30f); }
                    const size_t off = (size_t)(row0 + ai * 128 + m * 16) * DM + cb;
                    st16((bf16_t*)(ws + WS_GR) + off, pack8(r[0], r[1]));
                    st16((bf16_t*)(ws + WS_GS) + off, pack8(s[0], s[1]));
                }
        } else {
            if (wc == 0) {
#pragma unroll
                for (int ai = 0; ai < 2; ++ai)
#pragma unroll
                    for (int m = 0; m < 4; ++m) *(GAS f32x4*)((float*)(ws + WS_GKL) + (size_t)(row0 + ai * 128 + m * 16) * 16 + 4 * fq) = acc[ai][0][m][0];
            }
        }
        return false;
    }
};

struct EpiMerge {
    unsigned char* ws;
    __device__ __forceinline__ bool operator()(AccRef acc, const pg8::GUnit& u, int wr, int wc, int fr, int fq) const {
        const int row0 = u.pm * 256 + wr * 64 + fr, col0 = u.pn * 256 + 32 * wc + 8 * fq;
        const bf16_t* gp = (const bf16_t*)(ws + (u.aux ? WS_GS : WS_GR));
#pragma unroll
        for (int ai = 0; ai < 2; ++ai)
#pragma unroll
            for (int m = 0; m < 4; ++m)
#pragma unroll
                for (int bj = 0; bj < 2; ++bj) {
                    const size_t off = (size_t)(row0 + ai * 128 + m * 16) * DM + col0 + 128 * bj;
                    const u32x4 gw = *(const GAS u32x4*)(gp + off);
                    f32x4 v0 = acc[ai][bj][m][0], v1 = acc[ai][bj][m][1];
                    v0[0] *= bflo(gw[0]); v0[1] *= bfhi(gw[0]); v0[2] *= bflo(gw[1]); v0[3] *= bfhi(gw[1]);
                    v1[0] *= bflo(gw[2]); v1[1] *= bfhi(gw[2]); v1[2] *= bflo(gw[3]); v1[3] *= bfhi(gw[3]);
                    if (u.aux) *(GAS u32x4*)((bf16_t*)(ws + WS_MRG) + off) = MERGE_FP8 ? pack8(v0 * (1.0f / (O8_SCALE * W8_SCALE)), v1 * (1.0f / (O8_SCALE * W8_SCALE))) : pack8(v0, v1);
                    else { acc[ai][bj][m][0] = v0; acc[ai][bj][m][1] = v1; }
                }
        return u.aux == 0;
    }
};

struct EpiOut {
    const float* x; float* x1; bool dry;
    __device__ __forceinline__ bool operator()(AccRef acc, const pg8::GUnit& u, int wr, int wc, int fr, int fq) const {
        if (dry) { float sx = 0.f;
#pragma unroll
            for (int ai = 0; ai < 2; ++ai)
#pragma unroll
                for (int bj = 0; bj < 2; ++bj)
#pragma unroll
                    for (int m = 0; m < 4; ++m)
#pragma unroll
                        for (int n = 0; n < 2; ++n) sx += (acc[ai][bj][m][n][0] + acc[ai][bj][m][n][1]) + (acc[ai][bj][m][n][2] + acc[ai][bj][m][n][3]);
            if (sx == 1234.56789f) ((GAS float*)x1)[threadIdx.x] = sx;
            return false; }
        const int odd = fr & 1, rowe = u.pm * 256 + wr * 64 + (fr & ~1), colb = u.pn * 256 + 32 * wc + 16 * odd + 4 * fq;
#pragma unroll
        for (int ai = 0; ai < 2; ++ai)
#pragma unroll
            for (int m = 0; m < 4; ++m) {
                const size_t off = (size_t)(rowe + ai * 128 + m * 16) * DM + colb;
#pragma unroll
                for (int bj = 0; bj < 2; ++bj) {
                    const f32x4 v0 = acc[ai][bj][m][0], v1 = acc[ai][bj][m][1];
                    f32x4 snd = odd ? v0 : v1, rcv;
#pragma unroll
                    for (int j = 0; j < 4; ++j) rcv[j] = __shfl_xor(snd[j], 1);
                    const f32x4 d0 = odd ? rcv : v0, d1 = odd ? v1 : rcv;
                    const f32x4 x0 = *(const GAS f32x4*)(x + off + 128 * bj), x1v = *(const GAS f32x4*)(x + off + DM + 128 * bj);
                    *(GAS f32x4*)(x1 + off + 128 * bj) = x0 + d0; *(GAS f32x4*)(x1 + off + DM + 128 * bj) = x1v + d1;
                }
            }
        return false;
    }
};

struct EpiMoe1 {
    const float* b1; bf16_t* act; bool dry;
    __device__ __forceinline__ bool operator()(AccRef acc, const pg8::GUnit& u, int wr, int wc, int fr, int fq) const {
        if (dry) { float sx = 0.f;
#pragma unroll
            for (int ai = 0; ai < 2; ++ai)
#pragma unroll
                for (int bj = 0; bj < 2; ++bj)
#pragma unroll
                    for (int m = 0; m < 4; ++m)
#pragma unroll
                        for (int n = 0; n < 2; ++n) sx += (acc[ai][bj][m][n][0] + acc[ai][bj][m][n][1]) + (acc[ai][bj][m][n][2] + acc[ai][bj][m][n][3]);
            if (sx == 1234.56789f) ((GAS float*)act)[threadIdx.x] = sx;
            return false; }
        const int row0 = u.pm * 256 + wr * 64 + fr, cb = u.pn * 128 + 32 * wc + 8 * fq;
        const float* bp = b1 + (size_t)u.aux * 4096 + cb;
        f32x4 bg[2], bl[2];
#pragma unroll
        for (int n = 0; n < 2; ++n) { bg[n] = *(const GAS f32x4*)(bp + 4 * n); bl[n] = *(const GAS f32x4*)(bp + 2048 + 4 * n); }
#pragma unroll
        for (int ai = 0; ai < 2; ++ai)
#pragma unroll
            for (int m = 0; m < 4; ++m) {
                f32x4 o[2];
#pragma unroll
                for (int n = 0; n < 2; ++n)
#pragma unroll
                    for (int j = 0; j < 4; ++j) {
#if MOE_FP8
                        const float glu = fminf(fmaf(acc[ai][0][m][n][j], W8_INV, bg[n][j]), 7.0f);
                        const float lin1 = __builtin_amdgcn_fmed3f(fmaf(acc[ai][1][m][n][j], W8_INV, bl[n][j] + 1.0f), -6.0f, 8.0f);
#else
                        const float glu = fminf(acc[ai][0][m][n][j] + bg[n][j], 7.0f);
                        const float lin1 = __builtin_amdgcn_fmed3f(acc[ai][1][m][n][j] + bl[n][j] + 1.0f, -6.0f, 8.0f);
#endif
                        o[n][j] = glu * __builtin_amdgcn_rcpf(1.0f + __builtin_amdgcn_exp2f(-1.702f * 1.4426950408889634f * glu)) * lin1;
                    }
#if MOE_FP8
                { u32x2 w8 = {pk4_fp8(o[0][0], o[0][1], o[0][2], o[0][3]), pk4_fp8(o[1][0], o[1][1], o[1][2], o[1][3])};
                  *(GAS u32x2*)((unsigned char*)act + (size_t)(row0 + ai * 128 + m * 16) * DFF + cb) = w8; }
#else
                *(GAS u32x4*)(act + (size_t)(row0 + ai * 128 + m * 16) * DFF + cb) = pack8(o[0], o[1]);
#endif
            }
        return false;
    }
};

#ifndef Y_FP8
#define Y_FP8 1
#endif
constexpr float Y8_SCALE = 32.0f, Y8_INV = 1.0f / 32.0f;
static_assert(MOE_FP8 && Y_FP8, "EpiMoe2 stores e4m3 rows");
struct EpiMoe2 {
    const float* b2; const float* gate; bf16_t* y; bool dry = false;
    __device__ __forceinline__ bool operator()(AccRef acc, const pg8::GUnit& u, int wr, int wc, int fr, int fq) const {
        if (dry) { float sx = 0.f;
#pragma unroll
            for (int ai = 0; ai < 2; ++ai)
#pragma unroll
                for (int bj = 0; bj < 2; ++bj)
#pragma unroll
                    for (int m = 0; m < 4; ++m)
#pragma unroll
                        for (int n = 0; n < 2; ++n) sx += (acc[ai][bj][m][n][0] + acc[ai][bj][m][n][1]) + (acc[ai][bj][m][n][2] + acc[ai][bj][m][n][3]);
            if (sx == 1234.56789f) ((GAS float*)y)[threadIdx.x] = sx;
            return false; }
        const int row0 = u.pm * 256 + wr * 64 + fr, cb = u.pn * 256 + 64 * wc + 16 * fq;
        const float* bp = b2 + (size_t)u.aux * DM + cb;
        const float sc = W8_INV;
        const f32x4 b00 = *(const GAS f32x4*)bp, b01 = *(const GAS f32x4*)(bp + 4), b10 = *(const GAS f32x4*)(bp + 8), b11 = *(const GAS f32x4*)(bp + 12);
#pragma unroll
        for (int ai = 0; ai < 2; ++ai)
#pragma unroll
            for (int m = 0; m < 4; ++m) {
                const int r = row0 + ai * 128 + m * 16; const float gs = ((const GAS float*)gate)[r] * Y8_SCALE;
                const f32x4 y00 = (acc[ai][0][m][0] * sc + b00) * gs, y01 = (acc[ai][0][m][1] * sc + b01) * gs, y10 = (acc[ai][1][m][0] * sc + b10) * gs, y11 = (acc[ai][1][m][1] * sc + b11) * gs;
                const u32x4 w8 = {pk4_fp8(clamp8(y00[0]), clamp8(y00[1]), clamp8(y00[2]), clamp8(y00[3])), pk4_fp8(clamp8(y01[0]), clamp8(y01[1]), clamp8(y01[2]), clamp8(y01[3])),
                                  pk4_fp8(clamp8(y10[0]), clamp8(y10[1]), clamp8(y10[2]), clamp8(y10[3])), pk4_fp8(clamp8(y11[0]), clamp8(y11[1]), clamp8(y11[2]), clamp8(y11[3]))};
                *(GAS u32x4*)((unsigned char*)y + (size_t)r * DM + cb) = w8;
            }
        return false;
    }
};

__device__ __forceinline__ att::BlockRef<att::bf16, att::bf16> att_ref(unsigned char* ws, int it) {
    const int g = it / 384, rem = it - g * 384, bh = rem >> 4, within = rem & 15, sh = 2 * g, L = 4096 >> sh, nqb = L >> 8;
    const int r = within / nqb, n = within - r * nqb;
    const size_t base = ((size_t)(g * 24 + bh) * 4096 + (size_t)r * L) * 128;
    att::BlockRef<att::bf16, att::bf16> br;
    br.Q = (const att::bf16*)(ws + WS_QA) + base + (size_t)n * 256 * 128; br.K = (const att::bf16*)(ws + WS_KA) + base; br.V = (const att::bf16*)(ws + WS_VA) + base;
    br.LSE = (float*)(ws + WS_LSE) + (size_t)(g * 24 + bh) * 4096 + (size_t)r * L + n * 256; br.P0 = n * 256;
    return br;
}
__device__ __forceinline__ void phase_attention(const Args& a, char* lds, int c, int G) {
    constexpr int NIT = 3 * 384;
    int it = c; if (it >= NIT) return;
    att::BlockRef<att::bf16, att::bf16> cur = att_ref(a.ws, it);
    att::Seam<att::bf16> S;
    att::causal_swa_prime<att::bf16, att::bf16>(cur, 129, lds, S);
    for (;;) {
        const bool last = it + G >= NIT;
        const att::BlockRef<att::bf16, att::bf16> nxt = last ? cur : att_ref(a.ws, it + G);
        const int skv = 4096 >> (2 * (it / 384));
        att::causal_swa_block<att::bf16, att::bf16>(cur, nxt, skv, 129, lds, S);
        if (last) break;
        cur = nxt; it += G;
    }
}

__device__ __forceinline__ void phase_gla(const Args& a, LAS unsigned char* lds, int c, int G) {
    const int tid = threadIdx.x, col = tid >> 4, dkg = tid & 15;
    constexpr int TB = 16;
    LAS float* sq = (LAS float*)lds;
    LAS float* sk = sq + TB * 256;
    LAS float* se = sk + TB * 256;
    LAS float* sv = se + TB * 256;
    unsigned char* ws = a.ws;
    for (int it = c; it < 256; it += G) {
        const int p = it >> 4, cc = it & 15, b = p >> 2, h = p & 3;
        float S[16], wg[16];
#pragma unroll
        for (int i = 0; i < 16; ++i) { S[i] = 0.f; wg[i] = ((const GAS float*)a.w_gk_up)[i * GLA_K + h * 256 + (tid & 255)]; }
        const float bgk = ((const GAS float*)a.b_gk)[h * 256 + (tid & 255)];
        for (int t0 = 0; t0 < SEQ; t0 += TB) {
            __syncthreads();
#pragma unroll
            for (int rep = 0; rep < 8; ++rep) {
                const int e = tid + 512 * rep, tk = e >> 8, d = e & 255;
                const size_t trow = (size_t)b * SEQ + t0 + tk;
                sq[e] = bf2f(((const GAS bf16_t*)(ws + WS_QB))[trow * GLA_K + h * 256 + d]);
                sk[e] = bf2f(((const GAS bf16_t*)(ws + WS_KB))[trow * GLA_K + h * 256 + d]);
                float z = bgk;
                const GAS f32x4* gl = (const GAS f32x4*)((const float*)(ws + WS_GKL) + trow * 16);
#pragma unroll
                for (int r = 0; r < 4; ++r) { const f32x4 g4 = gl[r]; z += g4[0] * wg[4 * r] + g4[1] * wg[4 * r + 1] + g4[2] * wg[4 * r + 2] + g4[3] * wg[4 * r + 3]; }
                const float ls = fminf(z, 0.f) - log1pf(__expf(-fabsf(z)));
                se[e] = __expf(ls * (1.0f / 16.0f));
            }
            { const int tk = tid >> 5, cl = tid & 31;
              sv[tid] = bf2f(((const GAS bf16_t*)(ws + WS_VB))[((size_t)b * SEQ + t0 + tk) * GLA_V + h * 512 + cc * 32 + cl]); }
            __syncthreads();
#pragma unroll 4
            for (int tk = 0; tk < TB; ++tk) {
                const float v = sv[tk * 32 + col];
                float o = 0.f;
#pragma unroll
                for (int i4 = 0; i4 < 4; ++i4) {
                    const f32x4 q4 = *(const LAS f32x4*)(sq + tk * 256 + dkg * 16 + 4 * i4), k4 = *(const LAS f32x4*)(sk + tk * 256 + dkg * 16 + 4 * i4), e4 = *(const LAS f32x4*)(se + tk * 256 + dkg * 16 + 4 * i4);
#pragma unroll
                    for (int j = 0; j < 4; ++j) { S[4 * i4 + j] = e4[j] * S[4 * i4 + j] + k4[j] * v; o += q4[j] * S[4 * i4 + j]; }
                }
                o += __shfl_xor(o, 1); o += __shfl_xor(o, 2); o += __shfl_xor(o, 4); o += __shfl_xor(o, 8);
                if (dkg == 0) ((GAS float*)(ws + WS_OGLA))[((size_t)b * SEQ + t0 + tk) * GLA_V + h * 512 + cc * 32 + col] = o * (1.0f / 16.0f);
            }
        }
    }
}

struct MixSet { float ls[6][3]; unsigned ov[6][3]; u32x4 ow[4], gbw[4]; };
__device__ __forceinline__ void mix_load(MixSet& X, const unsigned char* ws, int t, int lane) {
    const int b = t >> 12, tt = t & 4095;
#pragma unroll
    for (int hh = 0; hh < 6; ++hh)
#pragma unroll
        for (int g = 0; g < 3; ++g) { const int sh = 2 * g, L = 4096 >> sh; const size_t ridx = (size_t)((g * 4 + b) * 6 + hh) * 4096 + (size_t)(tt & ((1 << sh) - 1)) * L + (tt >> sh);
            X.ls[hh][g] = ((const GAS float*)(ws + WS_LSE))[ridx]; X.ov[hh][g] = ((const GAS unsigned*)(ws + WS_OG))[ridx * 64 + lane]; }
#pragma unroll
    for (int h = 0; h < 4; ++h) { X.ow[h] = *(const GAS u32x4*)((const bf16_t*)(ws + WS_OGLA) + (size_t)t * GLA_V + h * 512 + 8 * lane);
        X.gbw[h] = *(const GAS u32x4*)((const bf16_t*)(ws + WS_GB) + (size_t)t * GLA_V + h * 512 + 8 * lane); }
}
__device__ __forceinline__ void mix_compute(const MixSet& X, const Args& a, unsigned char* ws, int t, int lane) {
    bf16_t* orow = (bf16_t*)(ws + WS_OCAT) + (size_t)t * KCAT;
    unsigned char* orow8 = ws + WS_OCAT + (size_t)t * KCAT;
#pragma unroll
    for (int hh = 0; hh < 6; ++hh) {
        const float mx = fmaxf(X.ls[hh][0], fmaxf(X.ls[hh][1], X.ls[hh][2]));
        const float w0 = __expf(X.ls[hh][0] - mx), w1 = __expf(X.ls[hh][1] - mx), w2 = __expf(X.ls[hh][2] - mx), inv = __builtin_amdgcn_rcpf(w0 + w1 + w2);
        const float o0 = (w0 * bflo(X.ov[hh][0]) + w1 * bflo(X.ov[hh][1]) + w2 * bflo(X.ov[hh][2])) * inv, o1 = (w0 * bfhi(X.ov[hh][0]) + w1 * bfhi(X.ov[hh][1]) + w2 * bfhi(X.ov[hh][2])) * inv;
#if MERGE_FP8
        ((GAS unsigned short*)orow8)[hh * 64 + lane] = (unsigned short)__builtin_amdgcn_cvt_pk_fp8_f32(clamp8(o0 * O8_SCALE), clamp8(o1 * O8_SCALE), 0, false);
#else
        ((GAS unsigned*)orow)[hh * 64 + lane] = cvtpk(o0, o1);
#endif
    }
    const f32x4 g0 = *((const GAS f32x4*)(a.g_gla + 8 * lane)), g1 = *((const GAS f32x4*)(a.g_gla + 8 * lane + 4));
#pragma unroll
    for (int h = 0; h < 4; ++h) {
        const u32x4 ow = X.ow[h], gbw = X.gbw[h];
        const f32x4 v0 = {bflo(ow[0]), bfhi(ow[0]), bflo(ow[1]), bfhi(ow[1])}, v1 = {bflo(ow[2]), bfhi(ow[2]), bflo(ow[3]), bfhi(ow[3])};
        float s = (v0[0] * v0[0] + v0[1] * v0[1]) + (v0[2] * v0[2] + v0[3] * v0[3]) + (v1[0] * v1[0] + v1[1] * v1[1]) + (v1[2] * v1[2] + v1[3] * v1[3]);
        const float rstd = rsqrtf(wave_sum(s) * (1.f / 512.f) + NORM_EPS);
        float gb[8] = {bflo(gbw[0]), bfhi(gbw[0]), bflo(gbw[1]), bfhi(gbw[1]), bflo(gbw[2]), bfhi(gbw[2]), bflo(gbw[3]), bfhi(gbw[3])};
        f32x4 r0, r1;
#pragma unroll
        for (int j = 0; j < 4; ++j) { r0[j] = v0[j] * rstd * g0[j] * (gb[j] * sigmoidf_(gb[j])); r1[j] = v1[j] * rstd * g1[j] * (gb[4 + j] * sigmoidf_(gb[4 + j])); }
#if MERGE_FP8
        { const f32x4 s0 = r0 * O8_SCALE, s1 = r1 * O8_SCALE;
          const u32x2 w8 = {pk4_fp8(clamp8(s0[0]), clamp8(s0[1]), clamp8(s0[2]), clamp8(s0[3])), pk4_fp8(clamp8(s1[0]), clamp8(s1[1]), clamp8(s1[2]), clamp8(s1[3]))};
          *(GAS u32x2*)(orow8 + ATT_OUT + h * 512 + 8 * lane) = w8; }
#else
        *(GAS u32x4*)(orow + ATT_OUT + h * 512 + 8 * lane) = pack8(r0, r1);
#endif
    }
}
__device__ __forceinline__ void phase_mixpost(const Args& a, int vcu, int G) {
    const int tid = threadIdx.x, lane = tid & 63, wave = tid >> 6;
    unsigned char* ws = a.ws;
    const int gw = vcu * NWAVES + wave, NGW = G * NWAVES;
    int t = gw; if (t >= T) return;
    MixSet A, B;
    mix_load(A, ws, t, lane);
    for (;;) {
        const int tB = t + NGW; const bool hasB = tB < T;
        if (hasB) mix_load(B, ws, tB, lane);
        mix_compute(A, a, ws, t, lane);
        if (!hasB) break;
        const int tA = tB + NGW; const bool hasA = tA < T;
        if (hasA) mix_load(A, ws, tA, lane);
        mix_compute(B, a, ws, tB, lane);
        if (!hasA) break;
        t = tA;
    }
}

__device__ __forceinline__ void phase_router(const Args& a, LAS unsigned char* lds, int c, int G) {
    const int tid = threadIdx.x, lane = tid & 63, wave = __builtin_amdgcn_readfirstlane(tid >> 6), r32 = lane & 31, hi = lane >> 5;
    unsigned char* ws = a.ws;
    LAS float* P = (LAS float*)lds;
    LAS float* SS = P + 4 * 64 * 32;
    const float* X1 = (const float*)(ws + WS_X1);
    unsigned* cnt = (unsigned*)(ws + WS_CTL) + CW_CNT;
    for (int blk = c; blk < T / 64; blk += G) {
        const int t0 = blk * 64;
        __syncthreads();
        {
            const int mb = wave & 1, kq = wave >> 1, t = t0 + 32 * mb + r32;
            const GAS float* xr = (const GAS float*)X1 + (size_t)t * DM + 512 * kq + 8 * hi;
            const GAS bf16_t* wh = (const GAS bf16_t*)(ws + WS_WRH) + (size_t)r32 * DM + 512 * kq + 8 * hi;
            const GAS bf16_t* wl = (const GAS bf16_t*)(ws + WS_WRL) + (size_t)r32 * DM + 512 * kq + 8 * hi;
            f32x16 acc = {}; float ss = 0.f;
#pragma unroll 4
            for (int ks = 0; ks < 32; ++ks) {
                const f32x4 x0 = *(const GAS f32x4*)(xr + 16 * ks), x1 = *(const GAS f32x4*)(xr + 16 * ks + 4);
                const bf16x8 bh = *(const GAS bf16x8*)(wh + 16 * ks), bl = *(const GAS bf16x8*)(wl + 16 * ks);
                ss += (x0[0] * x0[0] + x0[1] * x0[1]) + (x0[2] * x0[2] + x0[3] * x0[3]) + (x1[0] * x1[0] + x1[1] * x1[1]) + (x1[2] * x1[2] + x1[3] * x1[3]);
                u32x4 hw = {cvtpk(x0[0], x0[1]), cvtpk(x0[2], x0[3]), cvtpk(x1[0], x1[1]), cvtpk(x1[2], x1[3])};
                u32x4 lw = {cvtpk(x0[0] - bflo(hw[0]), x0[1] - bfhi(hw[0])), cvtpk(x0[2] - bflo(hw[1]), x0[3] - bfhi(hw[1])),
                            cvtpk(x1[0] - bflo(hw[2]), x1[1] - bfhi(hw[2])), cvtpk(x1[2] - bflo(hw[3]), x1[3] - bfhi(hw[3]))};
                const bf16x8 ah = *reinterpret_cast<bf16x8*>(&hw), al = *reinterpret_cast<bf16x8*>(&lw);
                acc = __builtin_amdgcn_mfma_f32_32x32x16_bf16(ah, bh, acc, 0, 0, 0);
                acc = __builtin_amdgcn_mfma_f32_32x32x16_bf16(al, bh, acc, 0, 0, 0);
                acc = __builtin_amdgcn_mfma_f32_32x32x16_bf16(ah, bl, acc, 0, 0, 0);
            }
            ss += __shfl_xor(ss, 32);
            if (hi == 0) SS[kq * 64 + 32 * mb + r32] = ss;
#pragma unroll
            for (int r = 0; r < 16; ++r) { const int row = (r & 3) + 8 * (r >> 2) + 4 * hi; P[(kq * 64 + 32 * mb + row) * 32 + r32] = acc[r]; }
        }
        __syncthreads();
        {
            const int tw = t0 + 8 * wave;
            f32x4 xa[2][8], xb[2][8];
#define RT_LOAD(buf, q0) do { _Pragma("unroll") for (int q_ = 0; q_ < 2; ++q_) _Pragma("unroll") for (int j = 0; j < 8; ++j) buf[q_][j] = ((const GAS f32x4*)(X1 + (size_t)(tw + (q0) + q_) * DM))[lane + 64 * j]; } while (0)
#define RT_STORE(buf, q0) do { _Pragma("unroll") for (int q_ = 0; q_ < 2; ++q_) { const int tk_ = 8 * wave + (q0) + q_; \
                const float rs_ = rsqrtf((SS[tk_] + SS[64 + tk_] + SS[128 + tk_] + SS[192 + tk_]) * (1.f / DM) + NORM_EPS); \
                GAS unsigned* o_ = (GAS unsigned*)(ws + WS_H2 + (size_t)(t0 + tk_) * DM) + lane; \
                _Pragma("unroll") for (int j = 0; j < 8; ++j) { const f32x4 v = buf[q_][j], g = *((const GAS f32x4*)a.g_ffn + lane + 64 * j); \
                    o_[64 * j] = pk4_fp8(clamp8(v[0] * rs_ * g[0]), clamp8(v[1] * rs_ * g[1]), clamp8(v[2] * rs_ * g[2]), clamp8(v[3] * rs_ * g[3])); } } } while (0)
            RT_LOAD(xa, 0); RT_LOAD(xb, 2);
            int my_e = 0; float my_g = 0.f;
            const float br = ((const GAS float*)a.b_router)[r32];
#pragma unroll
            for (int s = 0; s < 4; ++s) {
                const int tk = 8 * wave + 2 * s + hi;
                const float rstd = rsqrtf((SS[tk] + SS[64 + tk] + SS[128 + tk] + SS[192 + tk]) * (1.f / DM) + NORM_EPS);
                float lg = (P[tk * 32 + r32] + P[(64 + tk) * 32 + r32] + P[(128 + tk) * 32 + r32] + P[(192 + tk) * 32 + r32]) * rstd + br;
                float tv[4]; int te[4];
#pragma unroll
                for (int k = 0; k < 4; ++k) {
                    float bv = lg; int bi = r32;
#pragma unroll
                    for (int o = 16; o >= 1; o >>= 1) { const float ov = __shfl_xor(bv, o); const int oi = __shfl_xor(bi, o); if (ov > bv || (ov == bv && oi < bi)) { bv = ov; bi = oi; } }
                    tv[k] = bv; te[k] = bi; if (r32 == bi) lg = -__builtin_inff();
                }
                const float e1 = __expf(tv[1] - tv[0]), e2 = __expf(tv[2] - tv[0]), e3 = __expf(tv[3] - tv[0]), inv = 1.0f / (1.0f + e1 + e2 + e3);
                if ((r32 >> 2) == s) { const int k = r32 & 3;
                    my_e = k == 0 ? te[0] : (k == 1 ? te[1] : (k == 2 ? te[2] : te[3]));
                    my_g = (k == 0 ? 1.0f : (k == 1 ? e1 : (k == 2 ? e2 : e3))) * inv; }
            }
            if (r32 < 16) {
                const int t = tw + 2 * (r32 >> 2) + hi, k = r32 & 3;
                const unsigned rk = atomicAdd(cnt + my_e, 1u);
                ((GAS int*)(ws + WS_TOPE))[t * 4 + k] = my_e; ((GAS float*)(ws + WS_TOPG))[t * 4 + k] = my_g; ((GAS int*)(ws + WS_RANK))[t * 4 + k] = (int)rk;
            }
            RT_STORE(xa, 0); RT_LOAD(xa, 4); RT_STORE(xb, 2); RT_LOAD(xb, 6); RT_STORE(xa, 4); RT_STORE(xb, 6);
#undef RT_LOAD
#undef RT_STORE
        }
    }
}

__device__ __forceinline__ void phase_scatter(const Args& a, LAS unsigned char* lds, int c, int G) {
    const int tid = threadIdx.x;
    unsigned char* ws = a.ws;
    LAS int* ps = (LAS int*)lds;
    __syncthreads();
    if (tid == 0) { int acc = 0; for (int e = 0; e < NE; ++e) { ps[e] = acc; const int cn = (int)((const GAS unsigned*)(ws + WS_CTL))[CW_CNT + e]; acc += (cn + 255) & ~255; } ps[NE] = acc; }
    __syncthreads();
    for (int i = c * 512 + tid; i < T * 4; i += G * 512) {
        const int e = ((const GAS int*)(ws + WS_TOPE))[i], rk = ((const GAS int*)(ws + WS_RANK))[i];
        const int dest = ps[e] + rk;
        ((GAS int*)(ws + WS_TOK))[dest] = i >> 2; ((GAS float*)(ws + WS_GATE))[dest] = ((const GAS float*)(ws + WS_TOPG))[i]; ((GAS int*)(ws + WS_SLOT))[i] = dest;
    }
    for (int e = c; e < NE; e += G) {
        const int cn = (int)((const GAS unsigned*)(ws + WS_CTL))[CW_CNT + e], end = ps[e + 1];
        for (int r = ps[e] + cn + tid; r < end; r += 512) { ((GAS int*)(ws + WS_TOK))[r] = 0; ((GAS float*)(ws + WS_GATE))[r] = 0.f; }
    }
    if (c == 0) {
        GAS int* te = (GAS int*)(ws + WS_TILEE);
        if (tid == 0) te[0] = ps[NE] >> 8;
        for (int rt = tid; rt < (ps[NE] >> 8); rt += 512) { int e = 0; while (e < NE - 1 && ps[e + 1] <= rt * 256) ++e; te[16 + rt] = e; }
    }
}

__device__ __forceinline__ void phase_final(const Args& a, int vcu, int G) {
    const int tid = threadIdx.x, lane = tid & 63, wave = tid >> 6;
    unsigned char* ws = a.ws;
    const int gw = vcu * NWAVES + wave, NGW = G * NWAVES;
    for (int t = gw; t < T; t += NGW) {
        int sl[4];
#pragma unroll
        for (int k = 0; k < 4; ++k) sl[k] = __builtin_amdgcn_readfirstlane(((const GAS int*)(ws + WS_SLOT))[t * 4 + k]);
        f32x4 v[4][2]; float s = 0.f;
#pragma unroll
        for (int i = 0; i < 4; ++i) {
            const GAS f32x4* xp = (const GAS f32x4*)((const float*)(ws + WS_X1) + (size_t)t * DM + 512 * i + 8 * lane);
            v[i][0] = xp[0]; v[i][1] = xp[1];
#pragma unroll
#if Y_FP8
            for (int k = 0; k < 4; ++k) { const u32x2 yw = *(const GAS u32x2*)(ws + WS_Y + (size_t)sl[k] * DM + 512 * i + 8 * lane);
                const f32x2 a0 = __builtin_amdgcn_cvt_pk_f32_fp8((int)yw[0], false), a1 = __builtin_amdgcn_cvt_pk_f32_fp8((int)yw[0], true), a2 = __builtin_amdgcn_cvt_pk_f32_fp8((int)yw[1], false), a3 = __builtin_amdgcn_cvt_pk_f32_fp8((int)yw[1], true);
                v[i][0][0] += a0[0] * Y8_INV; v[i][0][1] += a0[1] * Y8_INV; v[i][0][2] += a1[0] * Y8_INV; v[i][0][3] += a1[1] * Y8_INV;
                v[i][1][0] += a2[0] * Y8_INV; v[i][1][1] += a2[1] * Y8_INV; v[i][1][2] += a3[0] * Y8_INV; v[i][1][3] += a3[1] * Y8_INV; }
#else
            for (int k = 0; k < 4; ++k) { const u32x4 yw = *(const GAS u32x4*)((const bf16_t*)(ws + WS_Y) + (size_t)sl[k] * DM + 512 * i + 8 * lane);
                v[i][0][0] += bflo(yw[0]); v[i][0][1] += bfhi(yw[0]); v[i][0][2] += bflo(yw[1]); v[i][0][3] += bfhi(yw[1]);
                v[i][1][0] += bflo(yw[2]); v[i][1][1] += bfhi(yw[2]); v[i][1][2] += bflo(yw[3]); v[i][1][3] += bfhi(yw[3]); }
#endif
#pragma unroll
            for (int h = 0; h < 2; ++h) s += (v[i][h][0] * v[i][h][0] + v[i][h][1] * v[i][h][1]) + (v[i][h][2] * v[i][h][2] + v[i][h][3] * v[i][h][3]);
        }
        const float rstd = rsqrtf(wave_sum(s) * (1.f / DM) + NORM_EPS);
#pragma unroll
        for (int i = 0; i < 4; ++i) {
            const GAS f32x4* gp = (const GAS f32x4*)(a.g_final + 512 * i + 8 * lane);
            GAS f32x4* op = (GAS f32x4*)(a.out + (size_t)t * DM + 512 * i + 8 * lane);
            op[0] = v[i][0] * rstd * gp[0]; op[1] = v[i][1] * rstd * gp[1];
        }
    }
}
constexpr size_t WS_QIN = WS_ACT;
constexpr size_t WS_KST = WS_QIN + 32 * MiB;
constexpr size_t WS_VT = WS_KST + 32 * MiB;
constexpr size_t WS_AB = WS_VT + 64 * MiB;
constexpr size_t WS_DEC = WS_AB + 8 * MiB;
__device__ __forceinline__ int swap23(int p) { return (p & ~12) | ((p & 4) << 1) | ((p & 8) >> 1); }

__device__ __forceinline__ void phase_gla_prep(const Args& a, LAS unsigned char* lds, int c, int G) {
    const int tid = threadIdx.x, lane = tid & 63, wave = __builtin_amdgcn_readfirstlane(tid >> 6), r32 = lane & 31, hh = lane >> 5;
    const int d = tid & 255, half = tid >> 8;
    unsigned char* ws = a.ws;
    LAS float* sg = (LAS float*)lds;
    LAS unsigned char* qal = lds + 65536;
    LAS unsigned char* kal = qal + 64 * 528;
    LAS float* sgl = (LAS float*)(lds + 65536 + 2 * 64 * 528);
    LAS float* sE = sgl + 64 * 16;
    constexpr int PITCH = 528;
    for (int I = c; I < 1024; I += G) {
        const int h = I & 3, bn = I >> 2, b = bn >> 6, n = bn & 63;
        const size_t t0 = (size_t)b * SEQ + 64 * n;
        {
            u32x4 rq[4], rk[4], rv[8];
#pragma unroll
            for (int rep = 0; rep < 4; ++rep) { const int p = tid + 512 * rep, cr = p >> 5, ch = p & 31;
                rq[rep] = *(const GAS u32x4*)((const bf16_t*)(ws + WS_QB) + (t0 + cr) * GLA_K + h * 256 + 8 * ch);
                rk[rep] = *(const GAS u32x4*)((const bf16_t*)(ws + WS_KB) + (t0 + cr) * GLA_K + h * 256 + 8 * ch); }
#pragma unroll
            for (int rep = 0; rep < 8; ++rep) { const int p = tid + 512 * rep, cr = p >> 6, ch = p & 63;
                rv[rep] = *(const GAS u32x4*)((const bf16_t*)(ws + WS_VB) + (t0 + cr) * GLA_V + h * 512 + 8 * ch); }
            if (tid < 256) ((LAS f32x4*)sgl)[tid] = ((const GAS f32x4*)((const float*)(ws + WS_GKL) + t0 * 16))[tid];
#pragma unroll
            for (int rep = 0; rep < 4; ++rep) { const int p = tid + 512 * rep, cr = p >> 5, ch = p & 31;
                *(LAS u32x4*)(qal + cr * PITCH + 16 * ch) = rq[rep]; *(LAS u32x4*)(kal + cr * PITCH + 16 * ch) = rk[rep]; }
#pragma unroll
            for (int rep = 0; rep < 8; ++rep) { const int p = tid + 512 * rep, cr = p >> 6, ch = p & 63;
                *(LAS u32x4*)(lds + cr * 1024 + 16 * ch) = rv[rep]; }
        }
        float wg[16];
#pragma unroll
        for (int i = 0; i < 16; ++i) wg[i] = ((const GAS float*)a.w_gk_up)[i * GLA_K + h * 256 + d];
        const float bgk = ((const GAS float*)a.b_gk)[h * 256 + d];
        __syncthreads();
        {
            GAS u32x4* vo = (GAS u32x4*)((bf16_t*)(ws + WS_VT) + ((size_t)I * 16 + (tid >> 5)) * 4 * 512 + (tid & 31) * 8);
            const LAS bf16_t* vc = (const LAS bf16_t*)lds + tid;
#pragma unroll
            for (int c8 = 0; c8 < 8; ++c8) {
                unsigned short x[8];
#pragma unroll
                for (int j = 0; j < 8; ++j) x[j] = vc[(8 * c8 + j) * 512];
                u32x4 w = {(unsigned)x[0] | ((unsigned)x[1] << 16), (unsigned)x[2] | ((unsigned)x[3] << 16), (unsigned)x[4] | ((unsigned)x[5] << 16), (unsigned)x[6] | ((unsigned)x[7] << 16)};
                vo[(c8 >> 1) * 64 + (c8 & 1) * 32] = w;
            }
        }
        __syncthreads();
#pragma unroll 4
        for (int cc = 0; cc < 32; ++cc) {
            const int ct = 32 * half + cc;
            const LAS f32x4* gl = (const LAS f32x4*)(sgl + ct * 16);
            float z = bgk;
#pragma unroll
            for (int r = 0; r < 4; ++r) { const f32x4 g4 = gl[r]; z += g4[0] * wg[4 * r] + g4[1] * wg[4 * r + 1] + g4[2] * wg[4 * r + 2] + g4[3] * wg[4 * r + 3]; }
            const float ls = fminf(z, 0.f) - __logf(1.0f + __expf(-fabsf(z)));
            sg[ct * 256 + d] = ls * (1.0f / 16.0f);
        }
        __syncthreads();
        {
            float bref = 0.f, blast = 0.f;
#pragma unroll 8
            for (int ct = 0; ct < 64; ++ct) { blast += sg[ct * 256 + d]; if (ct == 32) bref = blast; }
            float bc = 0.f;
            if (half == 0) {
                sE[d] = __expf(bref);
#pragma unroll 8
                for (int ct = 0; ct < 64; ++ct) {
                    bc += sg[ct * 256 + d];
                    LAS bf16_t* qe = (LAS bf16_t*)(qal + ct * PITCH + 2 * d);
                    const float qv = bf2f(*qe) * (1.0f / 16.0f);
                    *qe = (bf16_t)(cvtpk(qv * __expf(bc - bref), 0.f) & 0xffffu);
                }
            } else {
                GAS u32x4* ko = (GAS u32x4*)((bf16_t*)(ws + WS_KST) + ((size_t)I * 8 + (d >> 5)) * 4 * 512 + (d & 31) * 8);
#pragma unroll
                for (int c8 = 0; c8 < 8; ++c8) {
                    float ks[8];
#pragma unroll
                    for (int j = 0; j < 8; ++j) {
                        const int ct = 8 * c8 + j;
                        bc += sg[ct * 256 + d];
                        LAS bf16_t* ke = (LAS bf16_t*)(kal + ct * PITCH + 2 * d);
                        const float kv = bf2f(*ke);
                        *ke = (bf16_t)(cvtpk(kv * __expf(bref - bc), 0.f) & 0xffffu);
                        ks[j] = kv * __expf(blast - bc);
                    }
                    u32x4 w = {cvtpk(ks[0], ks[1]), cvtpk(ks[2], ks[3]), cvtpk(ks[4], ks[5]), cvtpk(ks[6], ks[7])};
                    ko[(c8 >> 1) * 64 + (c8 & 1) * 32] = w;
                }
                ((GAS bf16_t*)(ws + WS_DEC))[(size_t)I * 256 + d] = (bf16_t)(cvtpk(__expf(blast), 0.f) & 0xffffu);
            }
        }
        __syncthreads();
#pragma unroll
        for (int rep = 0; rep < 4; ++rep) {
            const int p = tid + 512 * rep, R = p >> 6, L = p & 63, w_ = R >> 2, mt = (R >> 1) & 1, ks = R & 1, cq = 32 * mt + (L & 31), dk0 = 32 * w_ + 16 * ks + 4 * (L >> 5);
            const u32x2 lo = *(const LAS u32x2*)(qal + cq * PITCH + 2 * dk0), hi2 = *(const LAS u32x2*)(qal + cq * PITCH + 2 * (dk0 + 8));
            const f32x4 e0 = *(const LAS f32x4*)(sE + dk0), e1 = *(const LAS f32x4*)(sE + dk0 + 8);
            u32x4 o = {cvtpk(bflo(lo[0]) * e0[0], bfhi(lo[0]) * e0[1]), cvtpk(bflo(lo[1]) * e0[2], bfhi(lo[1]) * e0[3]),
                       cvtpk(bflo(hi2[0]) * e1[0], bfhi(hi2[0]) * e1[1]), cvtpk(bflo(hi2[1]) * e1[2], bfhi(hi2[1]) * e1[3])};
            *(GAS u32x4*)((bf16_t*)(ws + WS_QIN) + ((size_t)I * 32 + R) * 512 + L * 8) = o;
        }
        {
            const int ti = wave & 1, tj = (wave >> 1) & 1, kh = wave >> 2;
            f32x16 acc = {};
            if (!(ti == 0 && tj == 1)) {
#pragma unroll
                for (int ks = 0; ks < 8; ++ks) {
                    const bf16x8 af = *(const LAS bf16x8*)(qal + (32 * ti + r32) * PITCH + (128 * kh + 16 * ks + 8 * hh) * 2);
                    const bf16x8 bf = *(const LAS bf16x8*)(kal + (32 * tj + r32) * PITCH + (128 * kh + 16 * ks + 8 * hh) * 2);
                    acc = __builtin_amdgcn_mfma_f32_32x32x16_bf16(af, bf, acc, 0, 0, 0);
                }
            }
#pragma unroll
            for (int r = 0; r < 16; ++r) { const int row = 32 * ti + (r & 3) + 8 * (r >> 2) + 4 * hh; sg[kh * 4096 + row * 64 + 32 * tj + r32] = acc[r]; }
        }
        __syncthreads();
        {
            int ci = tid >> 3; const int cj0 = 8 * (tid & 7);
            asm volatile("" : "+v"(ci));
            float v[8];
#pragma unroll
            for (int j = 0; j < 8; ++j) { const float s = sg[ci * 64 + cj0 + j] + sg[4096 + ci * 64 + cj0 + j]; v[j] = (cj0 + j <= ci) ? s : 0.f; }
            u32x4 w = {cvtpk(v[0], v[1]), cvtpk(v[2], v[3]), cvtpk(v[4], v[5]), cvtpk(v[6], v[7])};
            *(GAS u32x4*)((bf16_t*)(ws + WS_AB) + (((size_t)I * 2 + (ci >> 5)) * 4 + ((tid & 7) >> 1)) * 512 + ((tid & 1) * 32 + (ci & 31)) * 8) = w;
        }
        __syncthreads();
    }
}

struct GlaSet { bf16x8 qf[4], kf[4], vf[4], af; u32x2 dc[4]; };
__device__ __forceinline__ void gla_load(GlaSet& X, const GAS bf16_t* qb, const GAS bf16_t* kb, const GAS bf16_t* vb, const GAS bf16_t* ab, const GAS bf16_t* db, int n, int mtw, int ksw) {
#pragma unroll
    for (int f = 0; f < 4; ++f) X.qf[f] = *(const GAS bf16x8*)(qb + (size_t)n * 4 * 32 * 512 + f * 512);
#pragma unroll
    for (int ks = 0; ks < 4; ++ks) { X.kf[ks] = *(const GAS bf16x8*)(kb + (size_t)n * 4 * 32 * 512 + ks * 512); X.vf[ks] = *(const GAS bf16x8*)(vb + (size_t)n * 4 * 64 * 512 + ks * 512); }
    X.af = *(const GAS bf16x8*)(ab + (size_t)n * 4 * 8 * 512 + (mtw * 4 + ksw) * 512);
#pragma unroll
    for (int q4 = 0; q4 < 4; ++q4) X.dc[q4] = *(const GAS u32x2*)(db + (size_t)n * 4 * 256 + 8 * q4);
}
__device__ __forceinline__ void phase_gla_seq(const Args& a, LAS unsigned char* lds, int c, int G) {
    const int tid = threadIdx.x, lane = tid & 63, w = __builtin_amdgcn_readfirstlane(tid >> 6), r32 = lane & 31, hh = lane >> 5;
    unsigned char* ws = a.ws;
    constexpr int RP = 68;
    LAS float* red = (LAS float*)lds;
    const int mtw = w & 1, ksw = w >> 1;
    for (int it = c; it < 256; it += G) {
        const int p = it >> 4, s = it & 15, b = p >> 2, h = p & 3;
        const size_t I0 = (size_t)b * 64 * 4 + h;
        const GAS bf16_t* qb = (const GAS bf16_t*)(ws + WS_QIN) + (I0 * 8 + w) * 4 * 512 + lane * 8;
        const GAS bf16_t* kb = (const GAS bf16_t*)(ws + WS_KST) + (I0 * 8 + w) * 4 * 512 + lane * 8;
        const GAS bf16_t* vb = (const GAS bf16_t*)(ws + WS_VT) + (I0 * 16 + s) * 4 * 512 + lane * 8;
        const GAS bf16_t* ab = (const GAS bf16_t*)(ws + WS_AB) + I0 * 8 * 512 + lane * 8;
        const GAS bf16_t* db = (const GAS bf16_t*)(ws + WS_DEC) + I0 * 256 + 32 * w + 4 * hh;
        GAS bf16_t* ob = (GAS bf16_t*)(ws + WS_OGLA) + ((size_t)b * SEQ + 4 * (tid >> 5)) * GLA_V + h * 512 + 32 * s + (tid & 31);
        f32x16 S = {};
        GlaSet A, B;
        gla_load(A, qb, kb, vb, ab, db, 0, mtw, ksw);
        __syncthreads();
#define GLA_STEP(X, n) do { \
            u32x4 s0 = {cvtpk(S[0], S[1]), cvtpk(S[2], S[3]), cvtpk(S[4], S[5]), cvtpk(S[6], S[7])}, s1 = {cvtpk(S[8], S[9]), cvtpk(S[10], S[11]), cvtpk(S[12], S[13]), cvtpk(S[14], S[15])}; \
            const bf16x8 sf0 = *reinterpret_cast<bf16x8*>(&s0), sf1 = *reinterpret_cast<bf16x8*>(&s1); \
            f32x16 o0 = {}, o1 = {}, U = {}; \
            o0 = __builtin_amdgcn_mfma_f32_32x32x16_bf16(X.qf[0], sf0, o0, 0, 0, 0); o0 = __builtin_amdgcn_mfma_f32_32x32x16_bf16(X.qf[1], sf1, o0, 0, 0, 0); \
            o1 = __builtin_amdgcn_mfma_f32_32x32x16_bf16(X.qf[2], sf0, o1, 0, 0, 0); o1 = __builtin_amdgcn_mfma_f32_32x32x16_bf16(X.qf[3], sf1, o1, 0, 0, 0); \
            if (mtw == 0) o0 = __builtin_amdgcn_mfma_f32_32x32x16_bf16(X.af, (ksw == 0 ? X.vf[0] : ksw == 1 ? X.vf[1] : ksw == 2 ? X.vf[2] : X.vf[3]), o0, 0, 0, 0); \
            else          o1 = __builtin_amdgcn_mfma_f32_32x32x16_bf16(X.af, (ksw == 0 ? X.vf[0] : ksw == 1 ? X.vf[1] : ksw == 2 ? X.vf[2] : X.vf[3]), o1, 0, 0, 0); \
            _Pragma("unroll") for (int ks = 0; ks < 4; ++ks) U = __builtin_amdgcn_mfma_f32_32x32x16_bf16(X.kf[ks], X.vf[ks], U, 0, 0, 0); \
            _Pragma("unroll") for (int q4 = 0; q4 < 4; ++q4) { S[4 * q4] = bflo(X.dc[q4][0]) * S[4 * q4] + U[4 * q4]; S[4 * q4 + 1] = bfhi(X.dc[q4][0]) * S[4 * q4 + 1] + U[4 * q4 + 1]; \
                S[4 * q4 + 2] = bflo(X.dc[q4][1]) * S[4 * q4 + 2] + U[4 * q4 + 2]; S[4 * q4 + 3] = bfhi(X.dc[q4][1]) * S[4 * q4 + 3] + U[4 * q4 + 3]; } \
            LAS float* rb = red + (((n) & 1) * 8 + w) * 32 * RP + r32 * RP + 4 * hh; \
            _Pragma("unroll") for (int q4 = 0; q4 < 4; ++q4) { \
                *(LAS f32x4*)(rb + 8 * q4) = (f32x4){o0[4 * q4], o0[4 * q4 + 1], o0[4 * q4 + 2], o0[4 * q4 + 3]}; \
                *(LAS f32x4*)(rb + 32 + 8 * q4) = (f32x4){o1[4 * q4], o1[4 * q4 + 1], o1[4 * q4 + 2], o1[4 * q4 + 3]}; } \
            __syncthreads(); \
            { const LAS float* rr = red + ((n) & 1) * 8 * 32 * RP + (tid & 31) * RP + 4 * (tid >> 5); f32x4 sum = *(const LAS f32x4*)rr; \
              _Pragma("unroll") for (int ww = 1; ww < 8; ++ww) sum += *(const LAS f32x4*)(rr + ww * 32 * RP); \
              const f32x4 sn = {__shfl_xor(sum[0], 1), __shfl_xor(sum[1], 1), __shfl_xor(sum[2], 1), __shfl_xor(sum[3], 1)};        \
              if ((tid & 1) == 0) { GAS bf16_t* op = ob + (size_t)(n) * 64 * GLA_V; *(GAS unsigned*)op = cvtpk(sum[0], sn[0]); *(GAS unsigned*)(op + GLA_V) = cvtpk(sum[1], sn[1]); \
                  *(GAS unsigned*)(op + 2 * GLA_V) = cvtpk(sum[2], sn[2]); *(GAS unsigned*)(op + 3 * GLA_V) = cvtpk(sum[3], sn[3]); } } \
        } while (0)
        for (int n = 0; n < 64; n += 2) {
            __builtin_amdgcn_s_waitcnt(0xF74);
            gla_load(B, qb, kb, vb, ab, db, n + 1, mtw, ksw);
            GLA_STEP(A, n);
            __builtin_amdgcn_s_waitcnt(0xF74);
            gla_load(A, qb, kb, vb, ab, db, n + 2 < 64 ? n + 2 : n, mtw, ksw);
            GLA_STEP(B, n + 1);
        }
#undef GLA_STEP
        __syncthreads();
    }
}
#ifndef MK_MULTI
#define MK_MULTI 0
#endif
constexpr int N_PHASES = 12;

union ArgsU { Args a; unsigned long long w[sizeof(Args) / 8]; };
static_assert(sizeof(Args) % 8 == 0, "Args size");
__device__ __forceinline__ Args load_args() {
    ArgsU u;
#if defined(__HIP_DEVICE_COMPILE__)
    const __attribute__((address_space(4))) unsigned long long* kp = (const __attribute__((address_space(4))) unsigned long long*)__builtin_amdgcn_kernarg_segment_ptr();
    asm volatile("" : "+s"(kp));
#pragma unroll
    for (int i = 0; i < (int)(sizeof(Args) / 8); ++i) u.w[i] = kp[i];
#endif
    return u.a;
}
#define ARGS() load_args()
__device__ __forceinline__ void run_p1(LAS unsigned char* lds, int G, int bx, int dry = 0, int ntk = DM / 64) {
    unsigned char* ws = ARGS().ws;
    { InProjSched S{(const char*)(ws + WS_H), (const char*)(ws + WS_WIN), T / 256, NT16, ntk, G, bx, (size_t)256 * DM * 2, (size_t)256 * DM * 2, false};
      EpiInProj<false> E{ws, dry};
      pg8::gemm_phase<EpiInProj<false>, InProjSched, false>(lds, S, E, DM * 2, DM * 2); }
    { const int c8 = (bx + ((T / 256) * NT8) % G) % G;
      InProjSched S{(const char*)(ws + WS_H8), (const char*)(ws + WS_WIN8), T / 256, NT8, ntk / 2, G, c8, (size_t)256 * DM, (size_t)256 * DM, true};
      EpiInProj<true> E{ARGS().ws, dry};
      pg8::gemm_phase<EpiInProj<true>, InProjSched, false, true>(lds, S, E, DM, DM); }
}
__device__ __forceinline__ void run_p5(LAS unsigned char* lds, int G, int bx) {
    unsigned char* ws = ARGS().ws;
    constexpr int EB = MERGE_FP8 ? 1 : 2;
    MergeSched S{(const char*)(ws + WS_OCAT), (const char*)(ws + WS_WM), T / 256, DM / 256, G, bx, (size_t)256 * KCAT * EB, (size_t)256 * KCAT * EB};
    EpiMerge E{ws};
    pg8::gemm_phase<EpiMerge, MergeSched, false, MERGE_FP8 != 0>(lds, S, E, KCAT * EB, KCAT * EB);
}
__device__ __forceinline__ void run_p6(LAS unsigned char* lds, int G, int bx, bool dry = false) {
    const Args args = ARGS(); unsigned char* ws = args.ws;
    DenseSched S{(const char*)(ws + WS_MRG), (const char*)(ws + WS_WO), T / 256, DM / 256, DM / 64, G, bx, (size_t)256 * DM * 2, (size_t)256 * DM * 2};
    EpiOut E{args.x, (float*)(ws + WS_X1), dry};
    pg8::gemm_phase<EpiOut, DenseSched, false>(lds, S, E, DM * 2, DM * 2);
}
__device__ __forceinline__ void run_p9(LAS unsigned char* lds, int G, int bx, bool dry = false, int ntk = 16) {
    const Args args = ARGS(); unsigned char* ws = args.ws;
#if MOE_FP8
    MoeSched S{(const char*)(ws + WS_H2), (const char*)(ws + WS_W1), load_tile_table(lds, ws), (const int*)(ws + WS_TOK), 16, G, bx, 0, (size_t)256 * DM, (size_t)4096 * DM, true, ntk};
    EpiMoe1 E{args.b_mlp1, (bf16_t*)(ws + WS_ACT), dry};
    pg8::gemm_phase<EpiMoe1, MoeSched, true, true>(lds, S, E, DM, DM);
#else
    MoeSched S{(const char*)(ws + WS_H2), (const char*)(ws + WS_W1), load_tile_table(lds, ws), (const int*)(ws + WS_TOK), 16, G, bx, 0, (size_t)256 * DM * 2, (size_t)4096 * DM * 2, true, 32};
    EpiMoe1 E{args.b_mlp1, (bf16_t*)(ws + WS_ACT), dry};
    pg8::gemm_phase<EpiMoe1, MoeSched, true>(lds, S, E, DM * 2, DM * 2);
#endif
}
__device__ __forceinline__ void run_p10(LAS unsigned char* lds, int G, int bx, bool dry = false) {
    const Args args = ARGS(); unsigned char* ws = args.ws;
#if MOE_FP8
    MoeSched S{(const char*)(ws + WS_ACT), (const char*)(ws + WS_W2), load_tile_table(lds, ws), (const int*)(ws + WS_TOK), 8, G, bx, (size_t)256 * DFF, (size_t)256 * DFF, (size_t)DM * DFF, false, 16};
    EpiMoe2 E{args.b_mlp2, (const float*)(ws + WS_GATE), (bf16_t*)(ws + WS_Y), dry};
    pg8::gemm_phase<EpiMoe2, MoeSched, false, true>(lds, S, E, DFF, DFF);
#else
    MoeSched S{(const char*)(ws + WS_ACT), (const char*)(ws + WS_W2), load_tile_table(lds, ws), (const int*)(ws + WS_TOK), 8, G, bx, (size_t)256 * DFF * 2, (size_t)256 * DFF * 2, (size_t)DM * DFF * 2, false, 32};
    EpiMoe2 E{args.b_mlp2, (const float*)(ws + WS_GATE), (bf16_t*)(ws + WS_Y)};
    pg8::gemm_phase<EpiMoe2, MoeSched, false>(lds, S, E, DFF * 2, DFF * 2);
#endif
}

#ifndef PHASE_MASK
#define PHASE_MASK 0xFFF
#endif
#ifndef EXP_DRY
#define EXP_DRY 1
#endif
#ifndef EXP_DRY9
#define EXP_DRY9 true
#endif
#ifndef EXP_NTK9
#define EXP_NTK9 16
#endif
#ifndef EXP_NTK
#define EXP_NTK (DM / 64)
#endif
#ifndef REPEAT_MASK
#define REPEAT_MASK 0
#endif
__global__ void __launch_bounds__(NWAVES * 64, 2) mega(Args args_unused) {
    extern __shared__ __attribute__((aligned(16))) unsigned char lds_raw[];
    LAS unsigned char* lds = (LAS unsigned char*)lds_raw;
    const int tid = threadIdx.x;
    const int G = gridDim.x, bx = blockIdx.x;
#define vcu ((int)((gridDim.x % 8 == 0) ? (blockIdx.x % 8) * (gridDim.x / 8) + blockIdx.x / 8 : blockIdx.x))
    volatile LAS unsigned* MISC = (volatile LAS unsigned*)(lds + MISC_OFF);
    if (tid < 16) MISC[tid] = 0u;
    __syncthreads();
    { const Args a0 = ARGS();
      if (tid == 0) (void)xb_add((unsigned*)(a0.ws + WS_CTL) + CW_BAR + XB_XCNT(xb_xcc_id()), 1u); }
#define lo (ARGS().ph_lo)
#define hi (ARGS().ph_hi)
#define IN(k) ((((PHASE_MASK) >> (k)) & 1) && lo <= (k) && (k) < hi)
#define BOTH(k) (IN(k) && IN((k) + 1))
#define REP(k) (((REPEAT_MASK) >> (k)) & 1)
#define GRID_BAR() do { XcdBarrier bar_; bar_.bar = (unsigned*)(ARGS().ws + WS_CTL) + CW_BAR; bar_.x = xb_xcc_id(); bar_.st = MISC + 8; xcd_barrier(bar_); } while (0)
#define PHASE(k, call) do { if (IN(k)) { call; if (REP(k)) { GRID_BAR(); call; } if (BOTH(k)) GRID_BAR(); } } while (0)

    PHASE(0, phase_prologue(ARGS(), lds, vcu, G));
    if (IN(1)) {
#if CVT_SPLIT
        if ((int)blockIdx.x < G - NCVT) run_p1(lds, G - NCVT, bx, 0);
        else phase_cvt_experts(ARGS(), lds, (int)blockIdx.x - (G - NCVT), NCVT);
#else
        run_p1(lds, G, bx, 0);
#endif
        if (REP(1)) { GRID_BAR(); run_p1(lds, G, bx, EXP_DRY, EXP_NTK); } if (BOTH(1)) GRID_BAR(); }
#if defined(GLA_NAIVE)
    if (IN(2)) { phase_attention(ARGS(), (char*)lds_raw, bx, G); __syncthreads(); }
    PHASE(3, phase_gla(ARGS(), lds, vcu, G));
#else
    if (IN(2)) { phase_attention(ARGS(), (char*)lds_raw, bx, G); __syncthreads(); if (REP(2)) { phase_attention(ARGS(), (char*)lds_raw, bx, G); __syncthreads(); } }
    { int two = 2; asm volatile("" : "+s"(two));
      if (((PHASE_MASK >> 2) & 1) && lo <= two && two < hi) { phase_gla_prep(ARGS(), lds, vcu, G); if (REP(2)) phase_gla_prep(ARGS(), lds, vcu, G); if (BOTH(2)) GRID_BAR(); } }
    PHASE(3, phase_gla_seq(ARGS(), lds, vcu, G));
#endif
    PHASE(4, phase_mixpost(ARGS(), vcu, G));
#ifdef EXTRA_BARS
    for (int xb_ = 0; xb_ < EXTRA_BARS; ++xb_) GRID_BAR();
#endif
    PHASE(5, run_p5(lds, G, bx));
    if (IN(6)) { run_p6(lds, G, bx, false); if (REP(6)) { GRID_BAR(); run_p6(lds, G, bx, EXP_DRY); } if (BOTH(6)) GRID_BAR(); }
    PHASE(7, phase_router(ARGS(), lds, vcu, G));
    PHASE(8, phase_scatter(ARGS(), lds, vcu, G));
    if (IN(9)) { run_p9(lds, G, bx, false); if (REP(9)) { GRID_BAR(); run_p9(lds, G, bx, EXP_DRY9, EXP_NTK9); } if (BOTH(9)) GRID_BAR(); }
    if (IN(10)) { run_p10(lds, G, bx, false); if (REP(10)) { GRID_BAR(); run_p10(lds, G, bx, true); } if (BOTH(10)) GRID_BAR(); }
    if (IN(11)) { phase_final(ARGS(), vcu, G); if (REP(11)) phase_final(ARGS(), vcu, G); }
#undef IN
#undef BOTH
#undef GRID_BAR
#undef lo
#undef hi
#undef vcu
}

extern "C" void kernel_launch(void* const* d_in, const int* in_sizes, int n_in, void* d_out, int out_size, void* d_ws, size_t ws_size, hipStream_t stream) {
    static int grid = 0;
    if (grid == 0) {
        if (n_in != 18 || out_size != T * DM || ws_size < WS_END) { fprintf(stderr, "kernel_launch: unexpected shapes (n_in %d out %d ws %zu need %zu)\n", n_in, out_size, ws_size, (size_t)WS_END); grid = -1; return; }
        int dev = 0, cus = 0;
        if (hipGetDevice(&dev) != hipSuccess || hipDeviceGetAttribute(&cus, hipDeviceAttributeMultiprocessorCount, dev) != hipSuccess) { grid = -1; return; }
        if (hipFuncSetAttribute((const void*)mega, hipFuncAttributeMaxDynamicSharedMemorySize, LDS_BYTES) != hipSuccess) { fprintf(stderr, "kernel_launch: hipFuncSetAttribute failed\n"); grid = -1; return; }
        int per_cu = 0;
        if (hipOccupancyMaxActiveBlocksPerMultiprocessor(&per_cu, (const void*)mega, NWAVES * 64, LDS_BYTES) != hipSuccess || per_cu < 1) fprintf(stderr, "kernel_launch: occupancy query says %d\n", per_cu);
        (void)hipGetLastError();
        grid = cus;
    }
    if (grid < 0) return;
    (void)hipMemsetAsync((char*)d_ws + WS_CTL, 0, CTL_ZERO_BYTES, stream);
    Args a{};
    a.x = (const float*)d_in[0]; a.pos = (const int*)d_in[1]; a.g_mix = (const float*)d_in[2]; a.w_in = (const float*)d_in[3]; a.w_gk_up = (const float*)d_in[4];
    a.b_gk = (const float*)d_in[5]; a.g_gla = (const float*)d_in[6]; a.w_oa = (const float*)d_in[7]; a.w_ob = (const float*)d_in[8]; a.w_out = (const float*)d_in[9];
    a.g_ffn = (const float*)d_in[10]; a.w_router = (const float*)d_in[11]; a.b_router = (const float*)d_in[12]; a.w_mlp1 = (const float*)d_in[13]; a.b_mlp1 = (const float*)d_in[14];
    a.w_mlp2 = (const float*)d_in[15]; a.b_mlp2 = (const float*)d_in[16]; a.g_final = (const float*)d_in[17];
    a.out = (float*)d_out; a.ws = (unsigned char*)d_ws;
#if MK_MULTI
    for (int p = 0; p < N_PHASES; ++p) { a.ph_lo = p; a.ph_hi = p + 1; hipLaunchKernelGGL(mega, dim3(grid), dim3(NWAVES * 64), LDS_BYTES, stream, a); }
#else
    a.ph_lo = 0; a.ph_hi = N_PHASES; hipLaunchKernelGGL(mega, dim3(grid), dim3(NWAVES * 64), LDS_BYTES, stream, a);
#endif
}
```

```cpp
#include <hip/hip_runtime.h>
#include <hip/hip_bf16.h>
#include <cstdio>
#include <cstdint>

#define GAS __attribute__((address_space(1)))
#define LAS __attribute__((address_space(3)))
typedef unsigned short bf16_t;
typedef float f32x4 __attribute__((ext_vector_type(4)));
typedef float f32x2 __attribute__((ext_vector_type(2)));
typedef float f32x16 __attribute__((ext_vector_type(16)));
typedef short bf16x8 __attribute__((ext_vector_type(8)));
typedef unsigned u32x4 __attribute__((ext_vector_type(4)));
typedef unsigned u32x2 __attribute__((ext_vector_type(2)));

constexpr int T = 16384, DM = 2048, SEQ = 4096, NB = 4;
constexpr int ATT_W = 2304, ATT_OUT = 768, NHEAD = 18, HPG = 6;
constexpr int GLA_K = 1024, GLA_V = 2048, GLA_DK = 256, GLA_DV = 512;
constexpr int IN_W = 17168;
constexpr int C_QA = 0, C_KA = 2304, C_VA = 4608, C_QB = 6912, C_KB = 7936, C_VB = 8960, C_GB = 11008, C_GKL = 13056, C_GA = 13072, C_GBT = 15120;
constexpr int NPAD_IN = 17408;
constexpr int KCAT = 2816;
constexpr int NE = 32, TOPK = 4, DFF = 2048;
constexpr int RMAX = T * TOPK + NE * 256;
constexpr float NORM_EPS = 1e-6f;

constexpr size_t MiB = 1u << 20;
constexpr size_t WS_CTL = 0;
constexpr size_t CTL_ZERO_BYTES = 1 * MiB;
constexpr size_t WS_WIN = 1 * MiB;
constexpr size_t WS_WM = WS_WIN + 68 * MiB;
constexpr size_t WS_WO = WS_WM + 11 * MiB;
constexpr size_t WS_W1 = WS_WO + 8 * MiB;
constexpr size_t WS_W2 = WS_W1 + 512 * MiB;
constexpr size_t WS_H = WS_W2 + 256 * MiB;
constexpr size_t WS_QA = WS_H + 64 * MiB;
constexpr size_t WS_KA = WS_QA + 72 * MiB;
constexpr size_t WS_VA = WS_KA + 72 * MiB;
constexpr size_t WS_OG = WS_VA + 72 * MiB;
constexpr size_t WS_LSE = WS_OG + 72 * MiB;
constexpr size_t WS_QB = WS_LSE + 72 * MiB;
constexpr size_t WS_KB = WS_QB + 32 * MiB;
constexpr size_t WS_VB = WS_KB + 32 * MiB;
constexpr size_t WS_GB = WS_VB + 64 * MiB;
constexpr size_t WS_GR = WS_GB + 64 * MiB;
constexpr size_t WS_GS = WS_GR + 64 * MiB;
constexpr size_t WS_GKL = WS_GS + 64 * MiB;
constexpr size_t WS_COS = WS_GKL + 1 * MiB;
constexpr size_t WS_SIN = WS_COS + 4 * MiB;
constexpr size_t WS_OGLA = WS_SIN + 4 * MiB;
constexpr size_t WS_OCAT = WS_OGLA + 128 * MiB;
constexpr size_t WS_MRG = WS_OCAT + 88 * MiB;
constexpr size_t WS_H8 = WS_MRG;
constexpr size_t WS_WIN8 = WS_MRG + 32 * MiB;
constexpr size_t WS_X1 = WS_MRG + 64 * MiB;
constexpr size_t WS_H2 = WS_X1 + 128 * MiB;
constexpr size_t WS_WRH = WS_H2 + 64 * MiB;
constexpr size_t WS_WRL = WS_WRH + 128 * 1024;
constexpr size_t WS_TOPE = WS_WRH + 1 * MiB;
constexpr size_t WS_TOPG = WS_TOPE + 256 * 1024;
constexpr size_t WS_RANK = WS_TOPG + 256 * 1024;
constexpr size_t WS_SLOT = WS_RANK + 256 * 1024;
constexpr size_t WS_TOK = WS_SLOT + 256 * 1024;
constexpr size_t WS_GATE = WS_TOK + 512 * 1024;
constexpr size_t WS_TILEE = WS_GATE + 512 * 1024;
constexpr size_t WS_ACT = WS_TOPE + 4 * MiB;
constexpr size_t WS_Y = WS_ACT + 288 * MiB;
constexpr size_t WS_END = WS_Y + 288 * MiB;
constexpr int CW_BAR = 4096;
constexpr int CW_CNT = 16384;

constexpr int NWAVES = 8;
constexpr int LDS_BYTES = 163840;
constexpr int MISC_OFF = 131072 + 8192;

__device__ __forceinline__ unsigned cvtpk(float lo, float hi) { unsigned r; asm volatile("v_cvt_pk_bf16_f32 %0, %1, %2" : "=v"(r) : "v"(lo), "v"(hi)); return r; }
__device__ __forceinline__ float bf2f(unsigned short b) { return __uint_as_float(((unsigned)b) << 16); }
__device__ __forceinline__ float bflo(unsigned w) { return __uint_as_float(w << 16); }
__device__ __forceinline__ float bfhi(unsigned w) { return __uint_as_float(w & 0xffff0000u); }
__device__ __forceinline__ float wave_sum(float v) {
#pragma unroll
    for (int o = 1; o < 64; o <<= 1) v += __shfl_xor(v, o);
    return v;
}
__device__ __forceinline__ float sigmoidf_(float x) { return __builtin_amdgcn_rcpf(1.0f + __expf(-x)); }
#define XB_TMO      128
#define XB_XCNT(j)  (256  + 64 * (j))
#define XB_XSUB(j)  (1280 + 64 * (j))
#define XB_XGEN(j)  (2304 + 64 * (j))
#define XB_TOP      3328
#define XB_TOPGEN   3392
#define XCD_BAR_WORDS 3456
#define XB_SPIN_CAP (1u << 18)

__device__ __forceinline__ unsigned xb_ld(unsigned* p)              { return __hip_atomic_load(p, __ATOMIC_RELAXED, __HIP_MEMORY_SCOPE_AGENT); }
__device__ __forceinline__ unsigned xb_add(unsigned* p, unsigned v) { return __hip_atomic_fetch_add(p, v, __ATOMIC_RELAXED, __HIP_MEMORY_SCOPE_AGENT); }
__device__ __forceinline__ unsigned xb_xcc_id() { return (unsigned)__builtin_amdgcn_s_getreg((3 << 11) | 20) & 0xFu; }
#define XB_SPIN(cond, bar) do { unsigned _sp = 0; while (cond) { __builtin_amdgcn_s_sleep(1); \
    if ((++_sp & 255u) == 0u) { if (xb_ld(&(bar)[XB_TMO])) break; if (_sp > XB_SPIN_CAP) { atomicAdd(&(bar)[XB_TMO], 1u); break; } } } } while (0)

struct XcdBarrier {
    unsigned* bar; unsigned x;
    volatile LAS unsigned* st;
};

__device__ __forceinline__ XcdBarrier xcd_barrier_post(unsigned* bar, volatile LAS unsigned* st) {
    XcdBarrier b; b.bar = bar; b.x = xb_xcc_id(); b.st = st;
    if (threadIdx.x == 0) (void)xb_add(&bar[XB_XCNT(b.x)], 1u);
    return b;
}
__device__ __forceinline__ void xcd_barrier_complete(unsigned* bar, unsigned x, unsigned& nloc, unsigned& nx) {
    const unsigned G = gridDim.x * gridDim.y * gridDim.z;
    unsigned sum, cnt, mine, sp = 0u;
    for (;;) {
        sum = 0u; cnt = 0u; mine = 0u;
#pragma unroll
        for (unsigned j = 0; j < 16; ++j) { const unsigned c = xb_ld(&bar[XB_XCNT(j)]); sum += c; cnt += (c > 0u) ? 1u : 0u; mine = (j == x) ? c : mine; }
        if (sum == G) break;
        __builtin_amdgcn_s_sleep(1);
        if ((++sp & 255u) == 0u) { if (xb_ld(&bar[XB_TMO])) break; if (sp > XB_SPIN_CAP) { atomicAdd(&bar[XB_TMO], 1u); break; } }
    }
    nloc = mine > 0u ? mine : 1u; nx = cnt > 0u ? cnt : 1u;
}

__device__ __forceinline__ void xcd_barrier(const XcdBarrier& b) {
    asm volatile("s_waitcnt vmcnt(0)" ::: "memory");
    __syncthreads();
    if (threadIdx.x == 0) {
        unsigned* bar = b.bar;
        __builtin_amdgcn_s_waitcnt(0);
        unsigned nloc = b.st[0], nx = b.st[1];
        if (nloc == 0u) { xcd_barrier_complete(bar, b.x, nloc, nx); b.st[0] = nloc; b.st[1] = nx; }
        const unsigned old = xb_add(&bar[XB_XSUB(b.x)], 1u);
        const unsigned gen = old / nloc;
        if (old + 1u == (gen + 1u) * nloc) {
            __builtin_amdgcn_fence(__ATOMIC_RELEASE, "agent");
            asm volatile("s_waitcnt vmcnt(0)" ::: "memory");
            const unsigned og = xb_add(&bar[XB_TOP], 1u);
            const unsigned tg = og / nx;
            if (og + 1u == (tg + 1u) * nx) xb_add(&bar[XB_TOPGEN], 1u);
            else XB_SPIN(xb_ld(&bar[XB_TOPGEN]) == tg, bar);
            __builtin_amdgcn_fence(__ATOMIC_ACQUIRE, "agent");
            xb_add(&bar[XB_XGEN(b.x)], 1u);
            asm volatile("s_waitcnt vmcnt(0)" ::: "memory");
        } else {
            XB_SPIN(xb_ld(&bar[XB_XGEN(b.x)]) == gen, bar);
            __builtin_amdgcn_fence(__ATOMIC_ACQUIRE, "agent");
            asm volatile("s_waitcnt vmcnt(0)" ::: "memory");
        }
    }
    __syncthreads();
}
namespace att {
constexpr int D = 128;
constexpr float THR = 8.f;
constexpr bool WSKIP = true;
constexpr long long ATT_O_FROM_Q = (long long)WS_OG - (long long)WS_QA, ATT_LSE_FROM_Q = (long long)WS_LSE - (long long)WS_QA;
constexpr float SCALE = 0.08838834764831845f;
constexpr int NW = 8, QBLK = 32, KVBLK = 64, QB = NW * QBLK;
constexpr int SHM_V = KVBLK * D * 2, SHM_K = KVBLK * D * 2;
constexpr int LDS_BYTES = 2 * SHM_V + 2 * SHM_K + NW * 64 * 4;

using bf16 = __hip_bfloat16;
typedef short bf16x8 __attribute__((ext_vector_type(8)));
typedef short s16x4 __attribute__((ext_vector_type(4)));
typedef float f32x16 __attribute__((ext_vector_type(16)));
typedef float f32x4 __attribute__((ext_vector_type(4)));
typedef unsigned u32x4 __attribute__((ext_vector_type(4)));
template <class A, class Bt> struct same_t { static constexpr bool v = false; };
template <class A> struct same_t<A, A> { static constexpr bool v = true; };

#define KSWZ(row, colB) ((row) * 256 + ((colB) ^ (((row) & 7) << 4)))
#define SBAR() __builtin_amdgcn_sched_barrier(0)
__device__ __forceinline__ int v_st(int k, int c) { const int kk = (k & ~0xC) | ((k & 4) << 1) | ((k & 8) >> 1); return ((kk >> 3) * 4 + (c >> 5)) * 512 + ((kk & 7) * 32 + (c & 31)) * 2; }
__device__ __forceinline__ int v_rd_base(int lane) { return ((lane & 3) << 3) | (((lane >> 2) & 3) << 6) | (((lane >> 4) & 1) << 5) | (((lane >> 5) & 1) << 8); }
constexpr int v_rd_off(int d0, int ks, int half) { return d0 * 512 + ks * 4096 + half * 2048; }
__device__ __forceinline__ int crow(int r, int hi) { return (r & 3) + 8 * (r >> 2) + 4 * hi; }
__device__ __forceinline__ unsigned cvtpk(float lo, float hi) {
    unsigned r; asm volatile("v_cvt_pk_bf16_f32 %0, %1, %2" : "=v"(r) : "v"(lo), "v"(hi)); return r;
}
__device__ __forceinline__ bf16x8 pack8(f32x4 a, f32x4 b) {
    u32x4 w = {cvtpk(a[0], a[1]), cvtpk(a[2], a[3]), cvtpk(b[0], b[1]), cvtpk(b[2], b[3])};
    return *reinterpret_cast<bf16x8*>(&w);
}
template <class T> __device__ __forceinline__ bf16x8 load8(const T* p) {
    if constexpr (same_t<T, float>::v) { return pack8(*(const f32x4*)p, *(const f32x4*)(p + 4)); }
    else { return *reinterpret_cast<const bf16x8*>(p); }
}
__device__ __forceinline__ void mask_tile(f32x16& p0, f32x16& p1, int dq, unsigned W) {
    const float NEG = -__builtin_inff();
#pragma unroll
    for (int r = 0; r < 16; ++r) {
        const int c = (r & 3) + 8 * (r >> 2);
        if ((unsigned)(dq - c) >= W) p0[r] = NEG;
        if ((unsigned)(dq - c - 32) >= W) p1[r] = NEG;
    }
}
__device__ __forceinline__ void partialSM(f32x16& p0, f32x16& p1, float& m_reg, float& mn, float& alpha) {
    float pmax = p0[0]; for (int r = 1; r < 16; ++r) pmax = fmaxf(pmax, p0[r]); for (int r = 0; r < 16; ++r) pmax = fmaxf(pmax, p1[r]);
    { auto rr = __builtin_amdgcn_permlane32_swap(__float_as_uint(pmax), __float_as_uint(pmax), false, false);
      pmax = fmaxf(__uint_as_float(rr[0]), __uint_as_float(rr[1])); }
    constexpr float C2 = 1.4426950408889634f * SCALE;
    if (__builtin_expect(__all((pmax - m_reg) * SCALE <= THR), 1)) { mn = m_reg; alpha = 1.f; }
    else { mn = fmaxf(m_reg, pmax); alpha = __builtin_amdgcn_exp2f((m_reg - mn) * C2); m_reg = mn; }
    const float mnL = -mn * C2;
    for (int r = 0; r < 16; ++r) p0[r] = fmaf(p0[r], C2, mnL); for (int r = 0; r < 16; ++r) p1[r] = fmaf(p1[r], C2, mnL);
    for (int r = 0; r < 16; ++r) p0[r] = __builtin_amdgcn_exp2f(p0[r]);
}
__device__ __forceinline__ void finishSM(f32x16& p0, f32x16& p1, float alpha, float& l_reg, bf16x8& pa0, bf16x8& pa1, bf16x8& pa2, bf16x8& pa3) {
    for (int r = 0; r < 16; ++r) p1[r] = __builtin_amdgcn_exp2f(p1[r]);
    float ps = 0; for (int r = 0; r < 16; ++r) ps += p0[r]; for (int r = 0; r < 16; ++r) ps += p1[r];
    { auto rr = __builtin_amdgcn_permlane32_swap(__float_as_uint(ps), __float_as_uint(ps), false, false);
      ps = __uint_as_float(rr[0]) + __uint_as_float(rr[1]); }
    l_reg = l_reg * alpha + ps;
#define PK4(P, B_, OUT) do { unsigned a0 = cvtpk(P[B_+0], P[B_+1]), a1 = cvtpk(P[B_+2], P[B_+3]);                          \
        unsigned b0 = cvtpk(P[B_+4], P[B_+5]), b1 = cvtpk(P[B_+6], P[B_+7]);                                             \
        auto r0 = __builtin_amdgcn_permlane32_swap(a0, b0, false, false); auto r1 = __builtin_amdgcn_permlane32_swap(a1, b1, false, false); \
        u32x4 w = {r0[0], r1[0], r0[1], r1[1]}; OUT = *reinterpret_cast<bf16x8*>(&w); } while (0)
    PK4(p0, 0, pa0); PK4(p0, 8, pa1); PK4(p1, 0, pa2); PK4(p1, 8, pa3);
#undef PK4
}
template <int KB, bool SK>
__device__ __forceinline__ void qkt(f32x16& p0, f32x16& p1, const char* K_lds, int r32, int hi, const bf16x8* qr, bool act) {
    if (SK && !act) { const float NEG = -__builtin_inff();
#pragma unroll
        for (int r = 0; r < 16; ++r) { p0[r] = NEG; p1[r] = NEG; } return; }
    p0 = f32x16{}; p1 = f32x16{};
    const char* kb[4];
#pragma unroll
    for (int dd = 0; dd < 4; ++dd) kb[dd] = K_lds + KB * SHM_K + KSWZ(r32, (dd * 16 + hi * 8) * 2);
#pragma unroll
    for (int d0 = 0; d0 < 8; ++d0) { const char* a = kb[d0 & 3] + (d0 >> 2) * 128;
        bf16x8 b0 = *reinterpret_cast<const bf16x8*>(a);
        bf16x8 b1 = *reinterpret_cast<const bf16x8*>(a + 32 * 256);
        p0 = __builtin_amdgcn_mfma_f32_32x32x16_bf16(b0, qr[d0], p0, 0, 0, 0);
        p1 = __builtin_amdgcn_mfma_f32_32x32x16_bf16(b1, qr[d0], p1, 0, 0, 0); }
}
template <int VB, bool SK>
__device__ __forceinline__ void pv_tile(f32x16* o, int vb0, bf16x8 pa0, bf16x8 pa1, bf16x8 pa2, bf16x8 pa3, bool act) {
    if (SK && !act) return;
#define TRRD(dst, off) asm volatile("ds_read_b64_tr_b16 %0, %1 offset:%2" : "=&v"(dst) : "v"(vb0), "i"(off) : "memory")
#define PV_D0(d0) do { s16x4 l0, l1, l2, l3, h0, h1, h2, h3; constexpr int b_ = VB * SHM_V + v_rd_off(d0, 0, 0);     \
        TRRD(l0, b_); TRRD(h0, b_ + 2048); TRRD(l1, b_ + 4096); TRRD(h1, b_ + 6144); TRRD(l2, b_ + 8192); TRRD(h2, b_ + 10240); TRRD(l3, b_ + 12288); TRRD(h3, b_ + 14336); \
        asm volatile("s_waitcnt lgkmcnt(0)" ::: "memory"); SBAR();                 \
        o[d0] = __builtin_amdgcn_mfma_f32_32x32x16_bf16(pa0, (bf16x8){l0[0], l0[1], l0[2], l0[3], h0[0], h0[1], h0[2], h0[3]}, o[d0], 0, 0, 0);   \
        o[d0] = __builtin_amdgcn_mfma_f32_32x32x16_bf16(pa1, (bf16x8){l1[0], l1[1], l1[2], l1[3], h1[0], h1[1], h1[2], h1[3]}, o[d0], 0, 0, 0);   \
        o[d0] = __builtin_amdgcn_mfma_f32_32x32x16_bf16(pa2, (bf16x8){l2[0], l2[1], l2[2], l2[3], h2[0], h2[1], h2[2], h2[3]}, o[d0], 0, 0, 0);   \
        o[d0] = __builtin_amdgcn_mfma_f32_32x32x16_bf16(pa3, (bf16x8){l3[0], l3[1], l3[2], l3[3], h3[0], h3[1], h3[2], h3[3]}, o[d0], 0, 0, 0); } while (0)
    PV_D0(0); PV_D0(1); PV_D0(2); PV_D0(3);
#undef PV_D0
#undef TRRD
}

#ifndef OG_FP8
#define OG_FP8 1
#endif
template <class TIn, class TOut> struct BlockRef { const TIn* Q; const TIn* K; const TIn* V; float* LSE; int P0; unsigned char* O8; };
template <class TIn> struct Seam {
    bf16x8 qr[8];
    bf16x8 st_v0, st_v1, st_k0, st_k1; f32x4 sf0, sf1, sf2, sf3;
    f32x4 tq[16];
};
__device__ __forceinline__ int swa_jlo(int P0, int W) { const int lowk = P0 - W + 1; return lowk > 0 ? lowk / KVBLK : 0; }
#define ROW(p, k0, rr) ((p) + (size_t)((k0) + (rr)) * D + sc)
#define VMW() asm volatile("s_waitcnt vmcnt(0)" ::: "memory")
#define VMWN(n) asm volatile("s_waitcnt vmcnt(%0)" :: "i"(n) : "memory")
#define SLOAD_H(Kp, Vp, k0) do { S.st_v0 = load8<TIn>(ROW(Vp, k0, sr)); S.st_v1 = load8<TIn>(ROW(Vp, k0, 32 + sr));              \
                         S.st_k0 = load8<TIn>(ROW(Kp, k0, sr)); S.st_k1 = load8<TIn>(ROW(Kp, k0, 32 + sr)); } while (0)
#define SWRITE_HK(bf) do { *(bf16x8*)(K_lds + (bf) * SHM_K + kws) = S.st_k0; *(bf16x8*)(K_lds + (bf) * SHM_K + kws + 32 * 256) = S.st_k1; } while (0)
#define SWRITE_HV(bf) do { *(bf16x8*)(V_lds + (bf) * SHM_V + vst0) = S.st_v0; *(bf16x8*)(V_lds + (bf) * SHM_V + vst1) = S.st_v1; } while (0)
#define SWRITE_H(bf) do { SWRITE_HV(bf); SWRITE_HK(bf); } while (0)
#define SLOAD_F(p, k0) do { S.sf0 = *(const f32x4*)ROW(p, k0, sr); S.sf1 = *(const f32x4*)(ROW(p, k0, sr) + 4);                \
                            S.sf2 = *(const f32x4*)ROW(p, k0, 32 + sr); S.sf3 = *(const f32x4*)(ROW(p, k0, 32 + sr) + 4); } while (0)
#define SWRITE_KF(bf) do { *(bf16x8*)(K_lds + (bf) * SHM_K + kws) = pack8(S.sf0, S.sf1); *(bf16x8*)(K_lds + (bf) * SHM_K + kws + 32 * 256) = pack8(S.sf2, S.sf3); } while (0)
#define SWRITE_VF(bf) do { *(bf16x8*)(V_lds + (bf) * SHM_V + vst0) = pack8(S.sf0, S.sf1); *(bf16x8*)(V_lds + (bf) * SHM_V + vst1) = pack8(S.sf2, S.sf3); } while (0)
template <class TIn, class TOut>
__device__ __forceinline__ void causal_swa_prime(const BlockRef<TIn, TOut>& cur, int W, char* lds, Seam<TIn>& S) {
    constexpr bool F32 = same_t<TIn, float>::v;
    const int tid = threadIdx.x, wid = __builtin_amdgcn_readfirstlane(tid >> 6), lane = tid & 63, r32 = lane & 31, hi = lane >> 5;
    const int sr = tid >> 4, sc = (tid & 15) * 8, kws = KSWZ(sr, sc * 2); char* K_lds = lds + 2 * SHM_V;
    const int kb0 = swa_jlo(cur.P0, W) * KVBLK;
    for (int d0 = 0; d0 < 8; ++d0) S.qr[d0] = load8<TIn>(cur.Q + (size_t)(wid * QBLK + r32) * D + d0 * 16 + hi * 8);
    if constexpr (F32) { SLOAD_F((const float*)cur.K, kb0); VMW(); SWRITE_KF(0); SBAR(); SLOAD_F((const float*)cur.V, kb0); }
    else { SLOAD_H(cur.K, cur.V, kb0); VMW(); SWRITE_HK(0); }
    __syncthreads();
}
template <class TIn, class TOut>
__device__ __forceinline__ void causal_swa_block(const BlockRef<TIn, TOut>& cur, const BlockRef<TIn, TOut>& nxt, int skv, int W, char* lds, Seam<TIn>& S) {
    constexpr bool F32 = same_t<TIn, float>::v;
    const int tid = threadIdx.x, wid = __builtin_amdgcn_readfirstlane(tid >> 6), lane = tid & 63, r32 = lane & 31, hi = lane >> 5;
    const int j_lo = swa_jlo(cur.P0, W);
    int j_hi = (cur.P0 + QB - 1) / KVBLK + 1; if (j_hi > skv / KVBLK) j_hi = skv / KVBLK;
    const int NT = j_hi - j_lo;
    const int kbn = swa_jlo(nxt.P0, W) * KVBLK;
    const int qlo = cur.P0 + wid * QBLK, qm = qlo + r32 - 4 * hi;
    char* V_lds = lds; char* K_lds = lds + 2 * SHM_V;
    float* ws = (float*)(lds + 2 * SHM_V + 2 * SHM_K) + wid * 64; float* li_l = ws, * al_l = ws + 32;
    float m_reg = -1e30f, l_reg = 0; f32x16 o[4] = {};
    const int sr = tid >> 4, sc = (tid & 15) * 8, vst0 = v_st(sr, sc), vst1 = v_st(32 + sr, sc), kws = KSWZ(sr, sc * 2);
    const int vb0 = (int)(uintptr_t)V_lds + v_rd_base(lane);
    const TIn* Kh = cur.K; const TIn* Vh = cur.V;
#define RESC(a) do { if (__any((a) < 1.f)) { if (hi == 0) al_l[r32] = (a); asm volatile("s_waitcnt lgkmcnt(0)" ::: "memory");              \
                     for (int d_ = 0; d_ < 4; ++d_) for (int r = 0; r < 16; ++r) o[d_][r] *= al_l[crow(r, hi)]; } } while (0)
#define KBASE(t) ((j_lo + (t)) * KVBLK)
#define ACT(t) (KBASE(t) <= qlo + QBLK - 1 && KBASE(t) + KVBLK - 1 >= qlo - W + 1)
#define MASKT(P0_, P1_, t) do { const int kb_ = KBASE(t); if ((!SK || ACT(t)) && (kb_ + KVBLK - 1 > qlo || kb_ <= qlo + QBLK - 1 - W)) mask_tile(P0_, P1_, qm - kb_, (unsigned)W); } while (0)
    constexpr int NQL = F32 ? 16 : 8;
    constexpr bool SK = WSKIP && !F32;
#define SEAM_K0() do { VMWN(NQL); if constexpr (F32) { SWRITE_KF(0); SBAR(); SLOAD_F((const float*)nxt.V, kbn); } else { SWRITE_HK(0); } SBAR(); } while (0)
    f32x16 pA0, pA1, pB0, pB1; float mnA, mnB, alA, alB; bf16x8 pa0, pa1, pa2, pa3;
    if constexpr (F32) { VMW(); SWRITE_VF(0); SBAR(); } else { SWRITE_HV(0); SBAR(); }
    if (NT > 1) { if constexpr (F32) SLOAD_F((const float*)Kh, KBASE(1)); else SLOAD_H(Kh, Vh, KBASE(1)); }
    SBAR(); qkt<0, SK>(pA0, pA1, K_lds, r32, hi, S.qr, ACT(0));
    if constexpr (F32) { if (NT > 1) { VMW(); SWRITE_KF(1); SBAR(); SLOAD_F((const float*)Vh, KBASE(1)); } }
    MASKT(pA0, pA1, 0); partialSM(pA0, pA1, m_reg, mnA, alA);
    if (NT > 1) { VMW(); if constexpr (F32) { SWRITE_VF(1); SBAR(); if (NT > 2) SLOAD_F((const float*)Kh, KBASE(2)); } else SWRITE_H(1); }
    __syncthreads();
#define HALF_STEP(PX0, PX1, mnX, alX, PY0, PY1, alY, t, KB, VB, SB) do {                                                      \
        SBAR(); qkt<KB, SK>(PX0, PX1, K_lds, r32, hi, S.qr, ACT(t));                                             \
        finishSM(PY0, PY1, alY, l_reg, pa0, pa1, pa2, pa3); SBAR();                                                           \
        if ((t) + 1 < NT) { if constexpr (F32) { VMW(); SWRITE_KF(SB); SBAR(); SLOAD_F((const float*)Vh, KBASE((t) + 1)); }  \
                            else { SLOAD_H(Kh, Vh, KBASE((t) + 1)); } SBAR(); }                                               \
        pv_tile<VB, SK>(o, vb0, pa0, pa1, pa2, pa3, ACT((t) - 1)); MASKT(PX0, PX1, (t)); partialSM(PX0, PX1, m_reg, mnX, alX);                                        \
        __syncthreads();                                                                                                      \
        if ((t) + 1 < NT) { VMW(); if constexpr (F32) { SWRITE_VF(SB); SBAR(); if ((t) + 2 < NT) SLOAD_F((const float*)Kh, KBASE((t) + 2)); } \
                            else { SWRITE_H(SB); } }                                                                          \
        RESC(alX); __syncthreads(); } while (0)
    for (int t = 1; t + 1 < NT; t += 2) {
        HALF_STEP(pB0, pB1, mnB, alB, pA0, pA1, alA, t, 1, 0, 0);
        HALF_STEP(pA0, pA1, mnA, alA, pB0, pB1, alB, t + 1, 0, 1, 1);
    }
    const bool even = (NT & 1) == 0;
    if (even) { SBAR(); qkt<1, SK>(pB0, pB1, K_lds, r32, hi, S.qr, ACT(NT - 1)); SBAR(); }
#define QROW(e) (nxt.Q + (size_t)(wid * QBLK + r32) * D + ((e) >> 1) * 16 + hi * 8 + ((e) & 1) * 4)
    if constexpr (F32) { SLOAD_F((const float*)nxt.K, kbn); SBAR();
#pragma unroll
        for (int e = 0; e < 8; ++e) S.tq[e] = *(const f32x4*)QROW(e); }
    else { SLOAD_H(nxt.K, nxt.V, kbn); SBAR();
#pragma unroll
        for (int d0 = 0; d0 < 8; ++d0) S.qr[d0] = load8<TIn>(nxt.Q + (size_t)(wid * QBLK + r32) * D + d0 * 16 + hi * 8); }
    SBAR();
    finishSM(pA0, pA1, alA, l_reg, pa0, pa1, pa2, pa3); SBAR();
    if constexpr (F32) {
#pragma unroll
        for (int e = 8; e < 16; ++e) S.tq[e] = *(const f32x4*)QROW(e); SBAR(); }
#undef QROW
    pv_tile<0, SK>(o, vb0, pa0, pa1, pa2, pa3, ACT(even ? NT - 2 : NT - 1));
    if (even) { MASKT(pB0, pB1, NT - 1); partialSM(pB0, pB1, m_reg, mnB, alB); __syncthreads(); RESC(alB);
        finishSM(pB0, pB1, alB, l_reg, pa0, pa1, pa2, pa3); SBAR(); pv_tile<1, SK>(o, vb0, pa0, pa1, pa2, pa3, ACT(NT - 1)); }
    SBAR(); SEAM_K0();
    if (hi == 0) { li_l[r32] = l_reg; cur.LSE[wid * QBLK + r32] = m_reg * SCALE + __logf(l_reg); } asm volatile("s_waitcnt lgkmcnt(0)" ::: "memory");
    float rli[16];
#pragma unroll
    for (int r = 0; r < 16; ++r) rli[r] = __builtin_amdgcn_rcpf(li_l[crow(r, hi)]);
    TOut* Ow = (TOut*)((char*)const_cast<TIn*>(cur.Q) + ATT_O_FROM_Q) + (size_t)(wid * QBLK) * D;
#pragma unroll
    for (int r = 0; r < 16; ++r) { const int orow = crow(r, hi);
#pragma unroll
        for (int d0 = 0; d0 < 4; ++d0) { const float v = o[d0][r] * rli[r];
            if constexpr (same_t<TOut, float>::v) { Ow[(size_t)orow * D + d0 * 32 + r32] = v; }
            else { const float vn = __shfl_xor(v, 1);
#if OG_FP8
                   if ((r32 & 1) == 0) *(unsigned short*)(cur.O8 + (size_t)(wid * QBLK + orow) * D + d0 * 32 + r32) = (unsigned short)__builtin_amdgcn_cvt_pk_fp8_f32(fminf(fmaxf(v * 16.f, -448.f), 448.f), fminf(fmaxf(vn * 16.f, -448.f), 448.f), 0, false);
#else
                   if ((r32 & 1) == 0) *(unsigned*)(Ow + (size_t)orow * D + d0 * 32 + r32) = cvtpk(v, vn);
#endif
                 } } }
    if constexpr (F32) {
#pragma unroll
        for (int d0 = 0; d0 < 8; ++d0) S.qr[d0] = pack8(S.tq[2 * d0], S.tq[2 * d0 + 1]); }
    __syncthreads();
#undef RESC
#undef KBASE
#undef ACT
#undef MASKT
#undef SEAM_K0
#undef HALF_STEP
}
#undef ROW
#undef VMW
#undef VMWN
#undef SLOAD_H
#undef SWRITE_HK
#undef SWRITE_HV
#undef SWRITE_H
#undef SLOAD_F
#undef SWRITE_KF
#undef SWRITE_VF

}
namespace pg8 {
#define PG8_LAS __attribute__((address_space(3)))
typedef unsigned short bf16_t;
typedef short bf16x8 __attribute__((ext_vector_type(8)));
typedef float f32x4 __attribute__((ext_vector_type(4)));
typedef unsigned u32x4 __attribute__((ext_vector_type(4)));
typedef unsigned u32x2 __attribute__((ext_vector_type(2)));
constexpr int BM = 256, BK = 64, HALF = 128, HTB = HALF * BK * 2  , STAGE_BYTES = 8 * HTB, NXCD = 8, WGM = 8;
constexpr int GT_OFF = 140800, GT_UNITS = 18;

__host__ __device__ __forceinline__ int lds_byte(int r, int c) { const int st = (r >> 4) * 2 + (c >> 5), rr = r & 15, cc = c & 31, ob = rr * 64 + cc * 2; return st * 1024 + (ob ^ (((ob >> 9) & 1) << 5)); }
__host__ __device__ __forceinline__ void stage_rc(int b, int& R, int& C) { const int st = b / 1024, sb = b % 1024, swz = sb ^ (((sb >> 9) & 1) << 5); R = (st >> 1) * 16 + swz / 64; C = (st & 1) * 32 + (swz % 64) / 2; }

__device__ __forceinline__ unsigned cvt_pk_bf16(float lo, float hi) { unsigned r; asm volatile("v_cvt_pk_bf16_f32 %0, %1, %2" : "=v"(r) : "v"(lo), "v"(hi)); return r; }

struct NoPre {};
struct GUnit {
    const char* A;
    const char* B;
    const int* rows;
    int nt;
    int pm, pn, aux;
};

template <int WGM_ = WGM>
__device__ __forceinline__ void tile_order(int L, int nM, int nN, int& pm, int& pn) {
    const int nwg = nM * nN; int wgid = L;
    { const int q = nwg / NXCD, r = nwg % NXCD, xcd = wgid % NXCD, off = wgid / NXCD; wgid = (xcd < r ? xcd * (q + 1) : r * (q + 1) + (xcd - r) * q) + off; }
    const int nig = WGM_ * nN, gid = wgid / nig, fm = gid * WGM_, gsz = (nM - fm) < WGM_ ? (nM - fm) : WGM_;
    pm = fm + ((wgid % nig) % gsz); pn = (wgid % nig) / gsz;
}

typedef int i32x8 __attribute__((ext_vector_type(8)));
typedef int i32x4_ __attribute__((ext_vector_type(4)));
template <class Epi, class Sched, bool GATHER, bool FP8 = false>
__device__ __forceinline__ void gemm_phase(PG8_LAS unsigned char* lds, const Sched& S, const Epi& E, const unsigned lda, const unsigned ldb) {
    const int tid = threadIdx.x, wid = __builtin_amdgcn_readfirstlane(tid >> 6), lane = tid & 63, wr = wid >> 2, wc = wid & 3, fr = lane & 15, fq = lane >> 4;
    unsigned voffA0[2], voffA1[2], voffB0[2]; int stR[2], stC[2];
#pragma unroll
    for (int i = 0; i < 2; ++i) { int R, C; stage_rc(tid * 16 + i * 8192, R, C); stR[i] = R; stC[i] = C;
        voffA0[i] = (unsigned)R * lda + (unsigned)C * 2u; voffA1[i] = (unsigned)(R + HALF) * lda + (unsigned)C * 2u;
        voffB0[i] = (unsigned)R * ldb + (unsigned)C * 2u; }
    const size_t kstep = (size_t)(BK * 2);
    const size_t hsA = GATHER ? 0 : (size_t)HALF * lda, hsB = (size_t)HALF * ldb;
    const unsigned ldsw = (unsigned)wid * 1024u;
    const int aoff = FP8 ? lds_byte(wr * 64 + fr, 16 * fq) : lds_byte(wr * 64 + fr, fq * 8), boff = FP8 ? lds_byte(wc * 32 + fr, 16 * fq) : lds_byte(wc * 32 + fr, fq * 8);
#define PG8_SA(b, h) (((b) * 2 + (h)) * HTB)
#define PG8_SB(b, h) ((4 + (b) * 2 + (h)) * HTB)
#define PG8_STAGE(bufoff, gbase, voff) do { _Pragma("unroll") for (int _i = 0; _i < 2; ++_i) \
        __builtin_amdgcn_global_load_lds((const unsigned*)((const char*)(gbase) + (voff)[_i]), (PG8_LAS unsigned*)(lds + (bufoff) + ldsw + _i * 8192), 16, 0, 0); } while (0)
#define PG8_STAGE_A1(bufoff, gbase) do { if constexpr (GATHER) { PG8_STAGE(bufoff, gbase, voffA1); } else { PG8_STAGE(bufoff, (gbase) + hsA, voffA0); } } while (0)
#define PG8_LD16(buf, base, c) (*(const PG8_LAS i32x4_*)(lds + (buf) + (base) + (c)))
#define PG8_LDA(dst, b, h) do { if constexpr (FP8) { _Pragma("unroll") for (int m = 0; m < 4; ++m) dst##8[m] = __builtin_shufflevector(PG8_LD16(PG8_SA(b, h), aoff, m * 2048), PG8_LD16(PG8_SA(b, h), aoff, m * 2048 + 16), 0, 1, 2, 3, 4, 5, 6, 7); } \
      else { _Pragma("unroll") for (int m = 0; m < 4; ++m) _Pragma("unroll") for (int k = 0; k < 2; ++k) dst[m][k] = *(const PG8_LAS bf16x8*)(lds + PG8_SA(b, h) + aoff + m * 2048 + k * 1024); } } while (0)
#define PG8_LDB(dst, b, h) do { if constexpr (FP8) { _Pragma("unroll") for (int n = 0; n < 2; ++n) dst##8[n] = __builtin_shufflevector(PG8_LD16(PG8_SB(b, h), boff, n * 2048), PG8_LD16(PG8_SB(b, h), boff, n * 2048 + 16), 0, 1, 2, 3, 4, 5, 6, 7); } \
      else { _Pragma("unroll") for (int n = 0; n < 2; ++n) _Pragma("unroll") for (int k = 0; k < 2; ++k) dst[n][k] = *(const PG8_LAS bf16x8*)(lds + PG8_SB(b, h) + boff + n * 2048 + k * 1024); } } while (0)
#define PG8_MMA(ai, bj, At, Bt) do { __builtin_amdgcn_s_setprio(1); if constexpr (FP8) { _Pragma("unroll") for (int m = 0; m < 4; ++m) _Pragma("unroll") for (int n = 0; n < 2; ++n) \
        asm volatile("v_mfma_scale_f32_16x16x128_f8f6f4 %0, %1, %2, %0, %3, %3 op_sel_hi:[0,0,0]" : "+v"(acc[ai][bj][m][n]) : "v"(Bt##8[n]), "v"(At##8[m]), "v"(sc8)); } \
      else { _Pragma("unroll") for (int m = 0; m < 4; ++m) _Pragma("unroll") for (int n = 0; n < 2; ++n) _Pragma("unroll") for (int k = 0; k < 2; ++k) \
        acc[ai][bj][m][n] = __builtin_amdgcn_mfma_f32_16x16x32_bf16(Bt[n][k], At[m][k], acc[ai][bj][m][n], 0, 0, 0); } __builtin_amdgcn_s_setprio(0); } while (0)
#define PG8_WAIT_V(n) asm volatile("s_waitcnt vmcnt(" #n ")" ::: "memory")
#define PG8_WAIT_L(n) asm volatile("s_waitcnt lgkmcnt(" #n ")" ::: "memory")
#define PG8_BAR __builtin_amdgcn_s_barrier()
#define PG8_SCHED __builtin_amdgcn_sched_barrier(0)
#define PG8_GATHER_OFFS(uidx) do { if constexpr (GATHER) { const PG8_LAS int* gr_ = gtab + (uidx) * 256; _Pragma("unroll") for (int _i = 0; _i < 2; ++_i) { \
        const unsigned r0_ = (unsigned)gr_[stR[_i]], r1_ = (unsigned)gr_[stR[_i] + HALF]; \
        voffA0[_i] = r0_ * lda + (unsigned)stC[_i] * 2u; voffA1[_i] = r1_ * lda + (unsigned)stC[_i] * 2u; } } } while (0)
    GUnit cur, nxt; int ui = 0;
    PG8_LAS int* gtab = (PG8_LAS int*)(lds + GT_OFF);
    if constexpr (GATHER) {
        int rv[GT_UNITS / 2];
#pragma unroll
        for (int j = 0; j < GT_UNITS / 2; ++j) { GUnit uu; rv[j] = S.next(2 * j + (tid >> 8), uu) ? ((const __attribute__((address_space(1))) int*)uu.rows)[tid & 255] : 0; }
#pragma unroll
        for (int j = 0; j < GT_UNITS / 2; ++j) gtab[(2 * j + (tid >> 8)) * 256 + (tid & 255)] = rv[j];
        __syncthreads();
    }
    if (!S.next(0, cur)) return;
    f32x4 acc[2][2][4][2];
#pragma unroll
    for (int a = 0; a < 2; ++a)
#pragma unroll
        for (int b = 0; b < 2; ++b)
#pragma unroll
            for (int m = 0; m < 4; ++m)
#pragma unroll
                for (int n = 0; n < 2; ++n) acc[a][b][m][n] = (f32x4){0.f, 0.f, 0.f, 0.f};
    bf16x8 At[4][2], B0[2][2], B1[2][2]; i32x8 At8[4], B08[2], B18[2];
    int sc8 = 0x7F7F7F7F; asm volatile("" : "+v"(sc8));
    const char* cA = cur.A; const char* cB = cur.B;
    PG8_GATHER_OFFS(0);
    PG8_STAGE(PG8_SB(0, 0), cB, voffB0); PG8_STAGE(PG8_SB(0, 1), (cB) + hsB, voffB0); PG8_STAGE(PG8_SA(0, 0), cA, voffA0); PG8_STAGE_A1(PG8_SA(0, 1), cA);
    if (wr == 1) PG8_BAR;
    PG8_WAIT_V(2); PG8_BAR;
    PG8_STAGE(PG8_SB(1, 0), cB + kstep, voffB0); PG8_STAGE(PG8_SA(1, 0), cA + kstep, voffA0); PG8_STAGE(PG8_SB(1, 1), (cB + kstep) + hsB, voffB0);
    PG8_WAIT_V(6); PG8_BAR;
    for (;;) {
        const bool has_next = S.next(ui + 1, nxt);
        if (!has_next) { nxt = cur; }
        const char* nA = nxt.A; const char* nB = nxt.B;
        const int nt = cur.nt;
        [[maybe_unused]] typename Epi::Pre pre;
        if constexpr (Epi::HAS_PRE) { int tp = threadIdx.x; asm volatile("" : "+v"(tp)); const int wp = __builtin_amdgcn_readfirstlane(tp >> 6); E.preload(pre, cur, wp >> 2, wp & 3, tp & 15, (tp & 63) >> 4); }
        for (int t = 0; t < nt; t += 2) {
            const bool last = (t == nt - 2);
            asm volatile("" : "+v"(voffA0[0]), "+v"(voffA0[1]), "+v"(voffB0[0]), "+v"(voffB0[1]));
            if constexpr (GATHER) asm volatile("" : "+v"(voffA1[0]), "+v"(voffA1[1]));
            const char* a1 = cA + (size_t)(t + 1) * kstep;
            const char* a2 = last ? nA : cA + (size_t)(t + 2) * kstep; const char* b2 = last ? nB : cB + (size_t)(t + 2) * kstep;
            const char* a3 = a2 + kstep; const char* b3 = b2 + kstep;
            PG8_LDB(B0, 0, 0); PG8_LDB(B1, 0, 1); PG8_SCHED; PG8_LDA(At, 0, 0); PG8_STAGE_A1(PG8_SA(1, 1), a1);
            PG8_WAIT_V(8); PG8_WAIT_L(0); PG8_BAR; PG8_MMA(0, 0, At, B0); PG8_MMA(0, 1, At, B1); PG8_BAR; PG8_SCHED;
            if constexpr (GATHER) { if (last) { const int un_ = has_next ? (ui + 1 < GT_UNITS ? ui + 1 : GT_UNITS - 1) : ui; PG8_GATHER_OFFS(un_); } }
            PG8_LDA(At, 0, 1); PG8_STAGE(PG8_SB(0, 0), b2, voffB0); PG8_STAGE(PG8_SB(0, 1), (b2) + hsB, voffB0); PG8_STAGE(PG8_SA(0, 0), a2, voffA0);
            PG8_WAIT_V(8); PG8_WAIT_L(0); PG8_BAR; PG8_MMA(1, 0, At, B0); PG8_MMA(1, 1, At, B1); PG8_BAR; PG8_SCHED;
            PG8_LDB(B0, 1, 0); PG8_LDB(B1, 1, 1); PG8_SCHED; PG8_LDA(At, 1, 0); PG8_STAGE_A1(PG8_SA(0, 1), a2);
            PG8_WAIT_V(8); PG8_WAIT_L(0); PG8_BAR; PG8_MMA(0, 0, At, B0); PG8_MMA(0, 1, At, B1); PG8_BAR; PG8_SCHED;
            PG8_LDA(At, 1, 1); PG8_STAGE(PG8_SB(1, 0), b3, voffB0); PG8_STAGE(PG8_SB(1, 1), (b3) + hsB, voffB0); PG8_STAGE(PG8_SA(1, 0), a3, voffA0);
            PG8_WAIT_V(8); PG8_WAIT_L(0); PG8_BAR; PG8_MMA(1, 0, At, B0); PG8_MMA(1, 1, At, B1); PG8_BAR; PG8_SCHED;
            if constexpr (Epi::HAS_PRE) { if (t == 0) Epi::settle(pre); }
        }
        if (wr == 0) PG8_BAR;
        if constexpr (FP8) asm volatile("s_nop 15\n\ts_nop 15" ::: "memory");
        int tz = threadIdx.x; asm volatile("" : "+v"(tz));
        const int wz = __builtin_amdgcn_readfirstlane(tz >> 6);
        bool keep;
        if constexpr (Epi::HAS_PRE) keep = E(acc, cur, wz >> 2, wz & 3, tz & 15, (tz & 63) >> 4, pre); else keep = E(acc, cur, wz >> 2, wz & 3, tz & 15, (tz & 63) >> 4);
        if (!has_next) break;
        if (!keep) {
#pragma unroll
            for (int a = 0; a < 2; ++a)
#pragma unroll
                for (int b = 0; b < 2; ++b)
#pragma unroll
                    for (int m = 0; m < 4; ++m)
#pragma unroll
                        for (int n = 0; n < 2; ++n) acc[a][b][m][n] = (f32x4){0.f, 0.f, 0.f, 0.f};
        }
        cur = nxt; cA = nA; cB = nB; ++ui;
        if (wr == 1) PG8_BAR;
    }
    PG8_WAIT_V(0);
    PG8_BAR;
#undef PG8_SA
#undef PG8_SB
#undef PG8_STAGE
#undef PG8_STAGE_A1
#undef PG8_LDA
#undef PG8_LDB
#undef PG8_MMA
#undef PG8_LD16
#undef PG8_WAIT_V
#undef PG8_WAIT_L
#undef PG8_BAR
#undef PG8_SCHED
#undef PG8_GATHER_OFFS
}
}
struct Args {
    const float* x; const int* pos; const float* g_mix; const float* w_in; const float* w_gk_up; const float* b_gk; const float* g_gla;
    const float* w_oa; const float* w_ob; const float* w_out; const float* g_ffn; const float* w_router; const float* b_router;
    const float* w_mlp1; const float* b_mlp1; const float* w_mlp2; const float* b_mlp2; const float* g_final;
    float* out; unsigned char* ws; int ph_lo, ph_hi;
};

__device__ __forceinline__ int perm_c(int s) { return (s & 128) + (s & 96) + 8 * ((s >> 2) & 3) + 4 * ((s >> 4) & 1) + (s & 3); }
__device__ __forceinline__ int perm_y(int s) { return 64 * ((s >> 5) & 3) + 16 * ((s >> 2) & 3) + 8 * (s >> 7) + 4 * ((s >> 4) & 1) + (s & 3); }
__device__ __forceinline__ int rope_d(int s) { return 64 * ((s >> 4) & 1) + 16 * ((s >> 5) & 3) + 4 * ((s >> 2) & 3) + (s & 3); }
__device__ __forceinline__ int win_src(int pn, int s) {
    if (pn < 9)  return C_QA + pn * 256 + (s & 128) + rope_d(s);
    if (pn < 18) return C_KA + (pn - 9) * 256 + (s & 128) + rope_d(s);
    if (pn < 27) return C_VA + (pn - 18) * 256 + perm_c(s);
    if (pn < 31) return C_QB + (pn - 27) * 256 + perm_c(s);
    if (pn < 35) return C_KB + (pn - 31) * 256 + perm_c(s);
    if (pn < 43) return C_VB + (pn - 35) * 256 + perm_c(s);
    if (pn < 51) return C_GB + (pn - 43) * 256 + perm_c(s);
    if (pn < 67) return ((s & 128) ? C_GBT : C_GA) + (pn - 51) * 128 + (perm_c(s) & 127);
    return s < 16 ? C_GKL + s : -1;
}

#ifndef F8_GROUPS
#define F8_GROUPS 0x31
#endif
constexpr int grp_start(int g) { return g == 0 ? 0 : g == 1 ? 27 : g == 2 ? 35 : g == 3 ? 43 : g == 4 ? 51 : 67; }
constexpr int grp_size(int g) { return g == 0 ? 27 : g == 4 ? 16 : g == 5 ? 1 : 8; }
constexpr int grp_count(unsigned mask) { int n = 0; for (int g = 0; g < 6; ++g) if ((mask >> g) & 1) n += grp_size(g); return n; }
constexpr int NT8 = grp_count(F8_GROUPS), NT16 = 68 - NT8;
__device__ __forceinline__ int pn_of(int j, unsigned mask) {
#pragma unroll
    for (int g = 0; g < 6; ++g) if ((mask >> g) & 1) { if (j < grp_size(g)) return grp_start(g) + j; j -= grp_size(g); }
    return 67;
}
__device__ __forceinline__ int pn_of8(int j) { return pn_of(j, F8_GROUPS); }
__device__ __forceinline__ int pn_of16(int j) { return pn_of(j, 0x3F & ~(F8_GROUPS)); }
constexpr float H8_SCALE = 16.0f;
__device__ __forceinline__ void cvt_item(const float* W, int ldw, bf16_t* Bt, int ldbt, int koff, int tile, int kb, int map, LAS unsigned* scr, int tid) {
    const int k0 = kb * 64;
#pragma unroll
    for (int rep = 0; rep < 4; ++rep) {
        const int q = tid + 512 * rep, kp = q >> 6, s = (q & 63) * 4;
        int col;
        if (map == 0) col = tile * 256 + s;
        else if (map == 1) col = tile * 256 + perm_c(s);
        else if (map == 2) col = win_src(tile, s);
        else col = ((s & 128) ? 2048 : 0) + tile * 128 + (perm_c(s) & 127);
        f32x4 a = {0.f, 0.f, 0.f, 0.f}, b = {0.f, 0.f, 0.f, 0.f};
        if (col >= 0) { const GAS float* p = (const GAS float*)W + (size_t)(k0 + 2 * kp) * ldw + col; a = __builtin_nontemporal_load((const GAS f32x4*)p); b = __builtin_nontemporal_load((const GAS f32x4*)(p + ldw)); }
        scr[(s + 0) * 33 + kp] = cvtpk(a[0], b[0]); scr[(s + 1) * 33 + kp] = cvtpk(a[1], b[1]);
        scr[(s + 2) * 33 + kp] = cvtpk(a[2], b[2]); scr[(s + 3) * 33 + kp] = cvtpk(a[3], b[3]);
    }
    __syncthreads();
#pragma unroll
    for (int rep = 0; rep < 4; ++rep) {
        const int q = tid + 512 * rep, s = q >> 3, seg = q & 7;
        const LAS unsigned* r = scr + s * 33 + seg * 4;
        u32x4 o = {r[0], r[1], r[2], r[3]};
        *(GAS u32x4*)(Bt + (size_t)(tile * 256 + s) * ldbt + koff + k0 + seg * 8) = o;
    }
    __syncthreads();
}

#ifndef MOE_FP8
#define MOE_FP8 1
#endif
constexpr float W8_SCALE = 64.0f, W8_INV = 1.0f / 64.0f;
__device__ __forceinline__ unsigned pk4_fp8(float a, float b, float c, float d) {
    int r = __builtin_amdgcn_cvt_pk_fp8_f32(a, b, 0, false);
    r = __builtin_amdgcn_cvt_pk_fp8_f32(c, d, r, true);
    return (unsigned)r;
}
__device__ __forceinline__ float clamp8(float x) { return fminf(fmaxf(x, -448.f), 448.f); }
__device__ __forceinline__ void cvt_item8(const float* W, int ldw, unsigned char* Bt, int ldbt, int tile, int kb, int map, LAS unsigned* scr, int tid, int srct = 0, int koff = 0) {
    const int k0 = kb * 128;
#pragma unroll
    for (int rep = 0; rep < 4; ++rep) {
        const int q = tid + 512 * rep, kq = q >> 6, s = (q & 63) * 4;
        const int col = (map == 1) ? tile * 256 + perm_c(s) : (map == 2) ? win_src(srct, s) : ((s & 128) ? 2048 : 0) + tile * 128 + (perm_c(s) & 127);
        const GAS float* p = (const GAS float*)W + (size_t)(k0 + 4 * kq) * ldw + (col < 0 ? 0 : col);
        const float wsc = col < 0 ? 0.f : W8_SCALE;
        const f32x4 a0 = __builtin_nontemporal_load((const GAS f32x4*)p) * wsc, a1 = __builtin_nontemporal_load((const GAS f32x4*)(p + ldw)) * wsc, a2 = __builtin_nontemporal_load((const GAS f32x4*)(p + 2 * (size_t)ldw)) * wsc, a3 = __builtin_nontemporal_load((const GAS f32x4*)(p + 3 * (size_t)ldw)) * wsc;
        scr[(s + 0) * 33 + kq] = pk4_fp8(a0[0], a1[0], a2[0], a3[0]); scr[(s + 1) * 33 + kq] = pk4_fp8(a0[1], a1[1], a2[1], a3[1]);
        scr[(s + 2) * 33 + kq] = pk4_fp8(a0[2], a1[2], a2[2], a3[2]); scr[(s + 3) * 33 + kq] = pk4_fp8(a0[3], a1[3], a2[3], a3[3]);
    }
    __syncthreads();
#pragma unroll
    for (int rep = 0; rep < 4; ++rep) {
        const int q = tid + 512 * rep, s = q >> 3, seg = q & 7;
        const LAS unsigned* r = scr + s * 33 + seg * 4;
        u32x4 o = {r[0], r[1], r[2], r[3]};
        *(GAS u32x4*)(Bt + (size_t)(tile * 256 + s) * ldbt + koff + k0 + seg * 16) = o;
    }
    __syncthreads();
}

constexpr size_t WS_VT_EARLY = WS_ACT + 64 * MiB;
#ifndef V_RECORDS
#define V_RECORDS 1
#endif
#ifndef MERGE_FP8
#define MERGE_FP8 1
#endif
constexpr float O8_SCALE = 8.0f;
#ifndef CVT_SPLIT
#define CVT_SPLIT 0
#endif
#ifndef NCVT
#define NCVT 40
#endif
struct Cvt8Item { const GAS float* src; unsigned char* dst; int ldw; };
__device__ __forceinline__ void cvt8_decode(const Args& a, int it, int tid, Cvt8Item& X, int rep_col[4]) {
    constexpr int I4 = 32 * 16 * 16;
    const float* W; int ldw, tile, kb, map; unsigned char* Bt;
    if (it < I4) { const int e = it / 256, q = it % 256; W = a.w_mlp1 + (size_t)e * DM * 4096; ldw = 4096; Bt = a.ws + WS_W1 + (size_t)e * 4096 * DM; tile = q / 16; kb = q % 16; map = 3; }
    else { const int r = it - I4, e = r / 128, q = r % 128; W = a.w_mlp2 + (size_t)e * DM * DM; ldw = DM; Bt = a.ws + WS_W2 + (size_t)e * DM * DM; tile = q / 16; kb = q % 16; map = 1; }
    X.ldw = ldw; X.dst = Bt + (size_t)tile * 256 * DM + kb * 128;
    const int s = (tid & 63) * 4;
    const int col = (map == 1) ? tile * 256 + perm_y(s) : ((s & 128) ? 2048 : 0) + tile * 128 + (perm_c(s) & 127);
    X.src = (const GAS float*)W + (size_t)(kb * 128 + 4 * (tid >> 6)) * ldw + col;
    (void)rep_col;
}
__device__ __forceinline__ void cvt8_issue(const Cvt8Item& X, f32x4 (&v)[16]) {
#pragma unroll
    for (int rep = 0; rep < 4; ++rep)
#pragma unroll
        for (int k = 0; k < 4; ++k) v[rep * 4 + k] = __builtin_nontemporal_load((const GAS f32x4*)(X.src + (size_t)(32 * rep + k) * X.ldw));
}
__device__ __forceinline__ void cvt8_finish(const Cvt8Item& X, const f32x4 (&v)[16], LAS unsigned* scr, int tid) {
    const int s = (tid & 63) * 4;
#pragma unroll
    for (int rep = 0; rep < 4; ++rep) {
        const int kq = (tid >> 6) + 8 * rep;
        const f32x4 a0 = v[rep * 4] * W8_SCALE, a1 = v[rep * 4 + 1] * W8_SCALE, a2 = v[rep * 4 + 2] * W8_SCALE, a3 = v[rep * 4 + 3] * W8_SCALE;
        scr[(s + 0) * 33 + kq] = pk4_fp8(a0[0], a1[0], a2[0], a3[0]); scr[(s + 1) * 33 + kq] = pk4_fp8(a0[1], a1[1], a2[1], a3[1]);
        scr[(s + 2) * 33 + kq] = pk4_fp8(a0[2], a1[2], a2[2], a3[2]); scr[(s + 3) * 33 + kq] = pk4_fp8(a0[3], a1[3], a2[3], a3[3]);
    }
    __syncthreads();
#pragma unroll
    for (int rep = 0; rep < 4; ++rep) {
        const int q = tid + 512 * rep, sl = q >> 3, seg = q & 7;
        const LAS unsigned* r = scr + sl * 33 + seg * 4;
        u32x4 o = {r[0], r[1], r[2], r[3]};
        __builtin_nontemporal_store(o, (GAS u32x4*)(X.dst + (size_t)sl * DM + seg * 16));
    }
    __syncthreads();
}
__device__ __forceinline__ void phase_cvt_experts(const Args& a, LAS unsigned char* lds, int first, int stride) {
    const int tid = threadIdx.x;
    LAS unsigned* scr = (LAS unsigned*)lds;
    constexpr int NI = 32 * 16 * 16 + 32 * 8 * 16;
    int it = first; if (it >= NI) return;
    Cvt8Item XA, XB; f32x4 vA[16], vB[16]; int dummy[4];
    cvt8_decode(a, it, tid, XA, dummy); cvt8_issue(XA, vA);
    for (;;) {
        const int itB = it + stride; const bool hasB = itB < NI;
        if (hasB) { cvt8_decode(a, itB, tid, XB, dummy); cvt8_issue(XB, vB); }
        cvt8_finish(XA, vA, scr, tid);
        if (!hasB) break;
        const int itA = itB + stride; const bool hasA = itA < NI;
        if (hasA) { cvt8_decode(a, itA, tid, XA, dummy); cvt8_issue(XA, vA); }
        cvt8_finish(XB, vB, scr, tid);
        if (!hasA) break;
        it = itA;
    }
}

__device__ __forceinline__ void phase_prologue(const Args& a, LAS unsigned char* lds, int vcu, int G) {
    const int tid = threadIdx.x, lane = tid & 63, wave = tid >> 6;
    LAS unsigned* scr = (LAS unsigned*)lds;
    unsigned char* ws = a.ws;
#if MOE_FP8
    constexpr int I0 = NT16 * 32, I1 = MERGE_FP8 ? 8 * 6 : 8 * 12, I2 = MERGE_FP8 ? 8 * 16 : 8 * 32, I3 = 8 * 32, I0b = NT8 * 16, I4 = 32 * 16 * 16, I5 = 32 * 8 * 16;
#else
    constexpr int I0 = 68 * 32, I1 = 8 * 12, I2 = 8 * 32, I3 = 8 * 32, I4 = 32 * 16 * 32, I5 = 32 * 8 * 32;
#endif
    for (int it = vcu; it < I0 + I0b + I1 + I2 + I3; it += G) {
        int r = it;
        if (r < I0) { cvt_item(a.w_in, IN_W, (bf16_t*)(ws + WS_WIN), DM, 0, pn_of16(r / 32), r % 32, 2, scr, tid); continue; } r -= I0;
        if (r < I0b) { cvt_item8(a.w_in, IN_W, ws + WS_WIN8, DM, r / 16, r % 16, 2, scr, tid, pn_of8(r / 16)); continue; } r -= I0b;
#if MERGE_FP8
        if (r < I1) { cvt_item8(a.w_oa, DM, ws + WS_WM, KCAT, r / 6, r % 6, 1, scr, tid, 0, 0); continue; } r -= I1;
        if (r < I2) { cvt_item8(a.w_ob, DM, ws + WS_WM, KCAT, r / 16, r % 16, 1, scr, tid, 0, ATT_OUT); continue; } r -= I2;
#else
        if (r < I1) { cvt_item(a.w_oa, DM, (bf16_t*)(ws + WS_WM), KCAT, 0, r / 12, r % 12, 1, scr, tid); continue; } r -= I1;
        if (r < I2) { cvt_item(a.w_ob, DM, (bf16_t*)(ws + WS_WM), KCAT, ATT_OUT, r / 32, r % 32, 1, scr, tid); continue; } r -= I2;
#endif
        cvt_item(a.w_out, DM, (bf16_t*)(ws + WS_WO), DM, 0, r / 32, r % 32, 0, scr, tid);
    }
#if !CVT_SPLIT
    phase_cvt_experts(a, lds, vcu, G);
#endif
    const int gw = vcu * NWAVES + wave, NGW = G * NWAVES;
    f32x4 gmix[8];
#pragma unroll
    for (int j = 0; j < 8; ++j) gmix[j] = *((const GAS f32x4*)a.g_mix + lane + 64 * j);
    for (int m = gw; m < T; m += NGW) {
        const GAS f32x4* xr = (const GAS f32x4*)(a.x + (size_t)m * DM) + lane;
        f32x4 v[8]; float s = 0.f;
#pragma unroll
        for (int j = 0; j < 8; ++j) { v[j] = xr[64 * j]; s += (v[j][0] * v[j][0] + v[j][1] * v[j][1]) + (v[j][2] * v[j][2] + v[j][3] * v[j][3]); }
        const float rstd = rsqrtf(wave_sum(s) * (1.f / DM) + NORM_EPS);
        GAS u32x2* o = (GAS u32x2*)((bf16_t*)(ws + WS_H) + (size_t)m * DM) + lane;
        GAS unsigned* o8 = (GAS unsigned*)(ws + WS_H8 + (size_t)m * DM) + lane;
#pragma unroll
        for (int j = 0; j < 8; ++j) { const f32x4 g = gmix[j];
            const f32x4 hv = {v[j][0] * rstd * g[0], v[j][1] * rstd * g[1], v[j][2] * rstd * g[2], v[j][3] * rstd * g[3]};
            u32x2 w; w.x = cvtpk(hv[0], hv[1]); w.y = cvtpk(hv[2], hv[3]); o[64 * j] = w;
            o8[64 * j] = pk4_fp8(clamp8(hv[0] * H8_SCALE), clamp8(hv[1] * H8_SCALE), clamp8(hv[2] * H8_SCALE), clamp8(hv[3] * H8_SCALE)); }
    }
    for (int i = vcu * 512 + tid; i < T * 64; i += G * 512) {
        const int t = i >> 6, f = i & 63;
        const float inv = (float)pow(10000.0, -(double)f / 64.0);
        const float ang = (float)a.pos[t] * inv;
        float sn, cs; sincosf(ang, &sn, &cs);
        ((float*)(ws + WS_COS))[i] = cs; ((float*)(ws + WS_SIN))[i] = sn;
    }
    for (int i = vcu * 512 + tid; i < NE * DM; i += G * 512) {
        const int e = i / DM, k = i % DM;
        const float w = a.w_router[(size_t)k * NE + e] * a.g_ffn[k];
        const unsigned hi = cvtpk(w, 0.f) & 0xffffu; const float lo = w - __uint_as_float(hi << 16);
        ((bf16_t*)(ws + WS_WRH))[i] = (bf16_t)hi; ((bf16_t*)(ws + WS_WRL))[i] = (bf16_t)(cvtpk(lo, 0.f) & 0xffffu);
    }
}

struct DenseSched {
    const char* A; const char* B; int nM, nN, nt, G, c; size_t tsA, tsB;
    __device__ __forceinline__ bool next(int i, pg8::GUnit& u) const {
        const long L = (long)i * G + c; if (L >= (long)nM * nN) return false;
        pg8::tile_order((int)L, nM, nN, u.pm, u.pn);
        u.A = A + (size_t)u.pm * tsA; u.B = B + (size_t)u.pn * tsB; u.nt = nt; u.aux = 0; u.rows = nullptr; return true;
    }
};
struct InProjSched {
    const char* A; const char* B; int nM, nN, nt, G, c; size_t tsA, tsB; bool f8;
    __device__ __forceinline__ bool next(int i, pg8::GUnit& u) const {
        const long L = (long)i * G + c; if (L >= (long)nM * nN) return false;
        int j; pg8::tile_order((int)L, nM, nN, u.pm, j);
        u.pn = f8 ? pn_of8(j) : pn_of16(j);
        u.A = A + (size_t)u.pm * tsA; u.B = B + (size_t)(f8 ? j : u.pn) * tsB; u.nt = nt; u.aux = 0; u.rows = nullptr; return true;
    }
};
struct MergeSched {
    const char* A; const char* B; int nM, nN, G, c; size_t tsA, tsB;
    __device__ __forceinline__ bool next(int i, pg8::GUnit& u) const {
        const long L = (long)(i >> 1) * G + c; if (L >= (long)nM * nN) return false;
        pg8::tile_order((int)L, nM, nN, u.pm, u.pn);
        const int part = i & 1;
        constexpr int EB = MERGE_FP8 ? 1 : 2;
        u.A = A + (size_t)u.pm * tsA + (part ? ATT_OUT * EB : 0); u.B = B + (size_t)u.pn * tsB + (part ? ATT_OUT * EB : 0);
        u.nt = (part ? 32 : 12) / (MERGE_FP8 ? 2 : 1); u.aux = part; u.rows = nullptr; return true;
    }
};
#ifndef WGM_MOE
#define WGM_MOE 8
#endif
struct MoeSched {
    const char* A; const char* B; const LAS int* tl; const int* tok; int nN, G, c; size_t tsA, tsB, esB; bool gather; int nt;
    __device__ __forceinline__ bool next(int i, pg8::GUnit& u) const {
        const int nM = __builtin_amdgcn_readfirstlane(tl[0]);
        const long L = (long)i * G + c; if (L >= (long)nM * nN) return false;
        pg8::tile_order<WGM_MOE>((int)L, nM, nN, u.pm, u.pn);
        const int e = __builtin_amdgcn_readfirstlane(tl[16 + u.pm]);
        u.A = gather ? A : A + (size_t)u.pm * tsA; u.B = B + (size_t)e * esB + (size_t)u.pn * tsB; u.nt = nt; u.aux = e; u.rows = tok + u.pm * 256; return true;
    }
};
constexpr int TL_OFF = 139520;
__device__ __forceinline__ const LAS int* load_tile_table(LAS unsigned char* lds, const unsigned char* ws) {
    LAS int* tl = (LAS int*)(lds + TL_OFF);
    if (threadIdx.x < 304) tl[threadIdx.x] = ((const GAS int*)(ws + WS_TILEE))[threadIdx.x];
    __syncthreads();
    return tl;
}

typedef pg8::f32x4 (&AccRef)[2][2][4][2];
__device__ __forceinline__ u32x4 pack8(const f32x4 a, const f32x4 b) { u32x4 w = {cvtpk(a[0], a[1]), cvtpk(a[2], a[3]), cvtpk(b[0], b[1]), cvtpk(b[2], b[3])}; return w; }

template <bool F8>
struct EpiInProj {
    using Pre = pg8::NoPre; static constexpr bool HAS_PRE = false;
    unsigned char* ws; int dry; LAS unsigned char* elds = nullptr;
    __device__ __forceinline__ void st16(bf16_t* p, const u32x4 v) const {
        if (dry == 2) { asm volatile("" :: "v"(v[0]), "v"(v[1]), "v"(v[2]), "v"(v[3])); }
        else if (dry == 3) { *(GAS u32x4*)(ws + WS_Y + (size_t)blockIdx.x * 8192 + threadIdx.x * 16) = v; }
        else {
#if defined(EPI_STORE_SC1)
            asm volatile("global_store_dwordx4 %0, %1, off sc1\n\ts_nop 1" :: "v"((GAS u32x4*)p), "v"(v) : "memory");
#elif defined(EPI_STORE_SC01)
            asm volatile("global_store_dwordx4 %0, %1, off sc0 sc1\n\ts_nop 1" :: "v"((GAS u32x4*)p), "v"(v) : "memory");
#else
            *(GAS u32x4*)p = v;
#endif
        }
    }
    __device__ __forceinline__ bool operator()(AccRef acc, const pg8::GUnit& u, int wr, int wc, int fr, int fq) const {
        if (dry == 1) { float sx = 0.f;
#pragma unroll
            for (int ai = 0; ai < 2; ++ai)
#pragma unroll
                for (int bj = 0; bj < 2; ++bj)
#pragma unroll
                    for (int m = 0; m < 4; ++m)
#pragma unroll
                        for (int n = 0; n < 2; ++n) sx += (acc[ai][bj][m][n][0] + acc[ai][bj][m][n][1]) + (acc[ai][bj][m][n][2] + acc[ai][bj][m][n][3]);
            if (sx == 1234.56789f) ((GAS float*)(ws + WS_Y))[threadIdx.x] = sx;
            return false; }
        if constexpr (F8) {
#pragma unroll
            for (int ai = 0; ai < 2; ++ai)
#pragma unroll
                for (int bj = 0; bj < 2; ++bj)
#pragma unroll
                    for (int m = 0; m < 4; ++m)
#pragma unroll
                        for (int n = 0; n < 2; ++n) acc[ai][bj][m][n] *= (1.0f / (H8_SCALE * W8_SCALE));
        }
        const int pn = u.pn, row0 = u.pm * 256 + wr * 64 + fr;
        if (pn < 27) {
            const bool rope = pn < 18; const int hp = pn < 9 ? pn : (pn < 18 ? pn - 9 : pn - 18);
            bf16_t* dst = (bf16_t*)(ws + (pn < 9 ? WS_QA : (pn < 18 ? WS_KA : WS_VA)));
#pragma unroll
            for (int ai = 0; ai < 2; ++ai)
#pragma unroll
                for (int m = 0; m < 4; ++m) {
                    const int t = row0 + ai * 128 + m * 16, b = t >> 12, tt = t & 4095;
                    f32x4 cs = {1.f, 1.f, 1.f, 1.f}, sn = {0.f, 0.f, 0.f, 0.f};
                    if (rope) { cs = *(const GAS f32x4*)((const float*)(ws + WS_COS) + (size_t)t * 64 + 16 * wc + 4 * fq); sn = *(const GAS f32x4*)((const float*)(ws + WS_SIN) + (size_t)t * 64 + 16 * wc + 4 * fq); }
#pragma unroll
                    for (int bj = 0; bj < 2; ++bj) {
                        const int H = 2 * hp + bj, g = H / 6, hh = H - 6 * g, sh = 2 * g, L = 4096 >> sh;
                        const int ridx = (tt & ((1 << sh) - 1)) * L + (tt >> sh);
                        const f32x4 x1 = acc[ai][bj][m][0], x2 = acc[ai][bj][m][1];
                        f32x4 o1, o2;
                        if (rope) { o1 = x1 * cs - x2 * sn; o2 = x2 * cs + x1 * sn; } else { o1 = x1; o2 = x2; }
                        st16(dst + ((size_t)((g * 4 + b) * 6 + hh) * 4096 + ridx) * 128 + 32 * wc + 8 * fq, pack8(o1, o2));
                    }
                }
        } else if (V_RECORDS && pn >= 35 && pn < 43) {
            const int hV = (pn - 35) >> 1, s0 = ((pn - 35) & 1) * 8 + wc, hhv = fr >> 3, jv = fr & 7;
            LAS unsigned char* tw = elds + (wr * 4 + wc) * 1024;
#pragma unroll
            for (int ai = 0; ai < 2; ++ai) {
                const int tch = u.pm * 256 + wr * 64 + ai * 128;
                const size_t I = (size_t)((((tch >> 12) * 64 + ((tch & 4095) >> 6)) << 2) | hV);
#pragma unroll
                for (int m = 0; m < 4; ++m)
#pragma unroll
                    for (int bj = 0; bj < 2; ++bj) {
                        const u32x4 w = pack8(acc[ai][bj][m][0], acc[ai][bj][m][1]);
#pragma unroll
                        for (int cj = 0; cj < 8; ++cj) *(LAS unsigned short*)(tw + ((hhv * 32 + 8 * fq + cj) * 8 + jv) * 2) = (unsigned short)((w[cj >> 1] >> (16 * (cj & 1))) & 0xffffu);
                        asm volatile("" ::: "memory");
                        const u32x4 rec = *(const LAS u32x4*)(tw + (hhv * 32 + 8 * fq + jv) * 16);
                        asm volatile("" ::: "memory");
                        *(GAS u32x4*)((bf16_t*)(ws + WS_VT_EARLY) + ((I * 16 + (s0 + 4 * bj)) * 4 + m) * 512 + (hhv * 32 + 8 * fq + jv) * 8) = rec;
                    }
            }
        } else if (pn < 51) {
            bf16_t* dst; int ld, cb;
            if (pn < 31) { dst = (bf16_t*)(ws + WS_QB); ld = GLA_K; cb = (pn - 27) * 256; }
            else if (pn < 35) { dst = (bf16_t*)(ws + WS_KB); ld = GLA_K; cb = (pn - 31) * 256; }
            else if (pn < 43) { dst = (bf16_t*)(ws + WS_VB); ld = GLA_V; cb = (pn - 35) * 256; }
            else { dst = (bf16_t*)(ws + WS_GB); ld = GLA_V; cb = (pn - 43) * 256; }
#pragma unroll
            for (int ai = 0; ai < 2; ++ai)
#pragma unroll
                for (int m = 0; m < 4; ++m) {
                    bf16_t* rp = dst + (size_t)(row0 + ai * 128 + m * 16) * ld + cb + 32 * wc + 8 * fq;
#pragma unroll
                    for (int bj = 0; bj < 2; ++bj) st16(rp + 128 * bj, pack8(acc[ai][bj][m][0], acc[ai][bj][m][1]));
                }
        } else if (pn < 67) {
            const int cb = (pn - 51) * 128 + 32 * wc + 8 * fq;
#pragma unroll
            for (int ai = 0; ai < 2; ++ai)
#pragma unroll
                for (int m = 0; m < 4; ++m) {
                    f32x4 r[2], s[2];
#pragma unroll
                    for (int n = 0; n < 2; ++n)
#pragma unroll
                        for (int j = 0; j < 4; ++j) { const float ea = __expf(-acc[ai][0][m][n][j]), eb = __expf(-acc[ai][1][m][n][j]);
                            s[n][j] = __builtin_amdgcn_rcpf(1.0f + eb); r[n][j] = fminf((1.0f + eb) * __builtin_amdgcn_rcpf(1.0f + ea), 1e30f); }
                    const size_t off = (size_t)(row0 + ai * 128 + m * 16) * DM + cb;
                    st16((bf16_t*)(ws + WS_GR) + off, pack8(r[0], r[1]));
                    st16((bf16_t*)(ws + WS_GS) + off, pack8(s[0], s[1]));
                }
        } else {
            if (wc == 0) {
#pragma unroll
                for (int ai = 0; ai < 2; ++ai)
#pragma unroll
                    for (int m = 0; m < 4; ++m) *(GAS f32x4*)((float*)(ws + WS_GKL) + (size_t)(row0 + ai * 128 + m * 16) * 16 + 4 * fq) = acc[ai][0][m][0];
            }
        }
        return false;
    }
};

struct EpiMerge {
    using Pre = pg8::NoPre; static constexpr bool HAS_PRE = false;
    unsigned char* ws;
    __device__ __forceinline__ bool operator()(AccRef acc, const pg8::GUnit& u, int wr, int wc, int fr, int fq) const {
        const int row0 = u.pm * 256 + wr * 64 + fr, col0 = u.pn * 256 + 32 * wc + 8 * fq;
        const bf16_t* gp = (const bf16_t*)(ws + (u.aux ? WS_GS : WS_GR));
#pragma unroll
        for (int ai = 0; ai < 2; ++ai)
#pragma unroll
            for (int m = 0; m < 4; ++m)
#pragma unroll
                for (int bj = 0; bj < 2; ++bj) {
                    const size_t off = (size_t)(row0 + ai * 128 + m * 16) * DM + col0 + 128 * bj;
                    const u32x4 gw = *(const GAS u32x4*)(gp + off);
                    f32x4 v0 = acc[ai][bj][m][0], v1 = acc[ai][bj][m][1];
                    v0[0] *= bflo(gw[0]); v0[1] *= bfhi(gw[0]); v0[2] *= bflo(gw[1]); v0[3] *= bfhi(gw[1]);
                    v1[0] *= bflo(gw[2]); v1[1] *= bfhi(gw[2]); v1[2] *= bflo(gw[3]); v1[3] *= bfhi(gw[3]);
                    if (u.aux) *(GAS u32x4*)((bf16_t*)(ws + WS_MRG) + off) = MERGE_FP8 ? pack8(v0 * (1.0f / (O8_SCALE * W8_SCALE)), v1 * (1.0f / (O8_SCALE * W8_SCALE))) : pack8(v0, v1);
                    else { acc[ai][bj][m][0] = v0; acc[ai][bj][m][1] = v1; }
                }
        return u.aux == 0;
    }
};

struct EpiOut {
    using Pre = pg8::NoPre; static constexpr bool HAS_PRE = false;
    const float* x; float* x1; bool dry;
    __device__ __forceinline__ bool operator()(AccRef acc, const pg8::GUnit& u, int wr, int wc, int fr, int fq) const {
        if (dry) { float sx = 0.f;
#pragma unroll
            for (int ai = 0; ai < 2; ++ai)
#pragma unroll
                for (int bj = 0; bj < 2; ++bj)
#pragma unroll
                    for (int m = 0; m < 4; ++m)
#pragma unroll
                        for (int n = 0; n < 2; ++n) sx += (acc[ai][bj][m][n][0] + acc[ai][bj][m][n][1]) + (acc[ai][bj][m][n][2] + acc[ai][bj][m][n][3]);
            if (sx == 1234.56789f) ((GAS float*)x1)[threadIdx.x] = sx;
            return false; }
        const int odd = fr & 1, rowe = u.pm * 256 + wr * 64 + (fr & ~1), colb = u.pn * 256 + 32 * wc + 16 * odd + 4 * fq;
#pragma unroll
        for (int ai = 0; ai < 2; ++ai)
#pragma unroll
            for (int m = 0; m < 4; ++m) {
                const size_t off = (size_t)(rowe + ai * 128 + m * 16) * DM + colb;
#pragma unroll
                for (int bj = 0; bj < 2; ++bj) {
                    const f32x4 v0 = acc[ai][bj][m][0], v1 = acc[ai][bj][m][1];
                    f32x4 snd = odd ? v0 : v1, rcv;
#pragma unroll
                    for (int j = 0; j < 4; ++j) rcv[j] = __shfl_xor(snd[j], 1);
                    const f32x4 d0 = odd ? rcv : v0, d1 = odd ? v1 : rcv;
                    const f32x4 x0 = *(const GAS f32x4*)(x + off + 128 * bj), x1v = *(const GAS f32x4*)(x + off + DM + 128 * bj);
                    *(GAS f32x4*)(x1 + off + 128 * bj) = x0 + d0; *(GAS f32x4*)(x1 + off + DM + 128 * bj) = x1v + d1;
                }
            }
        return false;
    }
};

struct EpiMoe1 {
    const float* b1; bf16_t* act; bool dry;
    struct Pre { f32x4 bg[2], bl[2]; }; static constexpr bool HAS_PRE = true;
    __device__ __forceinline__ void preload(Pre& P, const pg8::GUnit& u, int wr, int wc, int fr, int fq) const {
        const float* bp = b1 + (size_t)u.aux * 4096 + u.pn * 128 + 32 * wc + 8 * fq;
#pragma unroll
        for (int n = 0; n < 2; ++n) { P.bg[n] = *(const GAS f32x4*)(bp + 4 * n); P.bl[n] = *(const GAS f32x4*)(bp + 2048 + 4 * n); }
    }
    static __device__ __forceinline__ void settle(Pre& P) { asm volatile("" : "+v"(P.bg[0]), "+v"(P.bg[1]), "+v"(P.bl[0]), "+v"(P.bl[1])); }
    __device__ __forceinline__ bool operator()(AccRef acc, const pg8::GUnit& u, int wr, int wc, int fr, int fq, const Pre& P) const {
        if (dry) { float sx = 0.f;
#pragma unroll
            for (int ai = 0; ai < 2; ++ai)
#pragma unroll
                for (int bj = 0; bj < 2; ++bj)
#pragma unroll
                    for (int m = 0; m < 4; ++m)
#pragma unroll
                        for (int n = 0; n < 2; ++n) sx += (acc[ai][bj][m][n][0] + acc[ai][bj][m][n][1]) + (acc[ai][bj][m][n][2] + acc[ai][bj][m][n][3]);
            if (sx == 1234.56789f) ((GAS float*)act)[threadIdx.x] = sx;
            return false; }
        const int row0 = u.pm * 256 + wr * 64 + fr, cb = u.pn * 128 + 32 * wc + 8 * fq;
        f32x4 bg[2] = {P.bg[0], P.bg[1]}, bl[2] = {P.bl[0], P.bl[1]};
#pragma unroll
        for (int ai = 0; ai < 2; ++ai)
#pragma unroll
            for (int m = 0; m < 4; ++m) {
                f32x4 o[2];
#pragma unroll
                for (int n = 0; n < 2; ++n)
#pragma unroll
                    for (int j = 0; j < 4; ++j) {
#if MOE_FP8
                        const float glu = fminf(fmaf(acc[ai][0][m][n][j], W8_INV, bg[n][j]), 7.0f);
                        const float lin1 = __builtin_amdgcn_fmed3f(fmaf(acc[ai][1][m][n][j], W8_INV, bl[n][j] + 1.0f), -6.0f, 8.0f);
#else
                        const float glu = fminf(acc[ai][0][m][n][j] + bg[n][j], 7.0f);
                        const float lin1 = __builtin_amdgcn_fmed3f(acc[ai][1][m][n][j] + bl[n][j] + 1.0f, -6.0f, 8.0f);
#endif
                        o[n][j] = glu * __builtin_amdgcn_rcpf(1.0f + __builtin_amdgcn_exp2f(-1.702f * 1.4426950408889634f * glu)) * lin1;
                    }
#if MOE_FP8
                { u32x2 w8 = {pk4_fp8(o[0][0], o[0][1], o[0][2], o[0][3]), pk4_fp8(o[1][0], o[1][1], o[1][2], o[1][3])};
                  *(GAS u32x2*)((unsigned char*)act + (size_t)(row0 + ai * 128 + m * 16) * DFF + cb) = w8; }
#else
                *(GAS u32x4*)(act + (size_t)(row0 + ai * 128 + m * 16) * DFF + cb) = pack8(o[0], o[1]);
#endif
            }
        return false;
    }
};

#ifndef Y_FP8
#define Y_FP8 1
#endif
constexpr float Y8_SCALE = 32.0f, Y8_INV = 1.0f / 32.0f;
static_assert(MOE_FP8 && Y_FP8, "EpiMoe2 stores e4m3 rows");
struct EpiMoe2 {
    const float* b2; const float* gate; bf16_t* y; bool dry = false;
    struct Pre { f32x4 b00, b01, b10, b11; float gt[2][4]; }; static constexpr bool HAS_PRE = true;
    __device__ __forceinline__ void preload(Pre& P, const pg8::GUnit& u, int wr, int wc, int fr, int fq) const {
        const float* bp = b2 + (size_t)u.aux * DM + u.pn * 256 + 64 * wc + 16 * fq;
        P.b00 = *(const GAS f32x4*)bp; P.b01 = *(const GAS f32x4*)(bp + 4); P.b10 = *(const GAS f32x4*)(bp + 8); P.b11 = *(const GAS f32x4*)(bp + 12);
        const int row0 = u.pm * 256 + wr * 64 + fr;
#pragma unroll
        for (int ai = 0; ai < 2; ++ai)
#pragma unroll
            for (int m = 0; m < 4; ++m) P.gt[ai][m] = ((const GAS float*)gate)[row0 + ai * 128 + m * 16];
    }
    static __device__ __forceinline__ void settle(Pre& P) { asm volatile("" : "+v"(P.b00), "+v"(P.b01), "+v"(P.b10), "+v"(P.b11), "+v"(P.gt[0][0]), "+v"(P.gt[0][1]), "+v"(P.gt[0][2]), "+v"(P.gt[0][3]), "+v"(P.gt[1][0]), "+v"(P.gt[1][1]), "+v"(P.gt[1][2]), "+v"(P.gt[1][3])); }
    __device__ __forceinline__ bool operator()(AccRef acc, const pg8::GUnit& u, int wr, int wc, int fr, int fq, const Pre& P) const {
        if (dry) { float sx = 0.f;
#pragma unroll
            for (int ai = 0; ai < 2; ++ai)
#pragma unroll
                for (int bj = 0; bj < 2; ++bj)
#pragma unroll
                    for (int m = 0; m < 4; ++m)
#pragma unroll
                        for (int n = 0; n < 2; ++n) sx += (acc[ai][bj][m][n][0] + acc[ai][bj][m][n][1]) + (acc[ai][bj][m][n][2] + acc[ai][bj][m][n][3]);
            if (sx == 1234.56789f) ((GAS float*)y)[threadIdx.x] = sx;
            return false; }
        const int row0 = u.pm * 256 + wr * 64 + fr, cb = u.pn * 256 + 64 * wc + 16 * fq;
        const float sc = W8_INV;
        const f32x4 b00 = P.b00, b01 = P.b01, b10 = P.b10, b11 = P.b11;
#pragma unroll
        for (int ai = 0; ai < 2; ++ai)
#pragma unroll
            for (int m = 0; m < 4; ++m) {
                const int r = row0 + ai * 128 + m * 16; const float gs = P.gt[ai][m] * Y8_SCALE;
                const f32x4 y00 = (acc[ai][0][m][0] * sc + b00) * gs, y01 = (acc[ai][0][m][1] * sc + b01) * gs, y10 = (acc[ai][1][m][0] * sc + b10) * gs, y11 = (acc[ai][1][m][1] * sc + b11) * gs;
                const u32x4 w8 = {pk4_fp8(clamp8(y00[0]), clamp8(y00[1]), clamp8(y00[2]), clamp8(y00[3])), pk4_fp8(clamp8(y01[0]), clamp8(y01[1]), clamp8(y01[2]), clamp8(y01[3])),
                                  pk4_fp8(clamp8(y10[0]), clamp8(y10[1]), clamp8(y10[2]), clamp8(y10[3])), pk4_fp8(clamp8(y11[0]), clamp8(y11[1]), clamp8(y11[2]), clamp8(y11[3]))};
                *(GAS u32x4*)((unsigned char*)y + (size_t)r * DM + cb) = w8;
            }
        return false;
    }
};

__device__ __forceinline__ att::BlockRef<att::bf16, att::bf16> att_ref(unsigned char* ws, int it) {
    const int g = it / 384, rem = it - g * 384, bh = rem >> 4, within = rem & 15, sh = 2 * g, L = 4096 >> sh, nqb = L >> 8;
    const int r = within / nqb, n = within - r * nqb;
    const size_t base = ((size_t)(g * 24 + bh) * 4096 + (size_t)r * L) * 128;
    att::BlockRef<att::bf16, att::bf16> br;
    br.Q = (const att::bf16*)(ws + WS_QA) + base + (size_t)n * 256 * 128; br.K = (const att::bf16*)(ws + WS_KA) + base; br.V = (const att::bf16*)(ws + WS_VA) + base;
    br.LSE = (float*)(ws + WS_LSE) + (size_t)(g * 24 + bh) * 4096 + (size_t)r * L + n * 256; br.P0 = n * 256;
    br.O8 = ws + WS_OG + base + (size_t)n * 256 * 128;
    return br;
}
__device__ __forceinline__ void phase_attention(const Args& a, char* lds, int c, int G) {
    constexpr int NIT = 3 * 384;
    int it = c; if (it >= NIT) return;
    att::BlockRef<att::bf16, att::bf16> cur = att_ref(a.ws, it);
    att::Seam<att::bf16> S;
    att::causal_swa_prime<att::bf16, att::bf16>(cur, 129, lds, S);
    for (;;) {
        const bool last = it + G >= NIT;
        const att::BlockRef<att::bf16, att::bf16> nxt = last ? cur : att_ref(a.ws, it + G);
        const int skv = 4096 >> (2 * (it / 384));
        att::causal_swa_block<att::bf16, att::bf16>(cur, nxt, skv, 129, lds, S);
        if (last) break;
        cur = nxt; it += G;
    }
}

__device__ __forceinline__ void phase_gla(const Args& a, LAS unsigned char* lds, int c, int G) {
    const int tid = threadIdx.x, col = tid >> 4, dkg = tid & 15;
    constexpr int TB = 16;
    LAS float* sq = (LAS float*)lds;
    LAS float* sk = sq + TB * 256;
    LAS float* se = sk + TB * 256;
    LAS float* sv = se + TB * 256;
    unsigned char* ws = a.ws;
    for (int it = c; it < 256; it += G) {
        const int p = it >> 4, cc = it & 15, b = p >> 2, h = p & 3;
        float S[16], wg[16];
#pragma unroll
        for (int i = 0; i < 16; ++i) { S[i] = 0.f; wg[i] = ((const GAS float*)a.w_gk_up)[i * GLA_K + h * 256 + (tid & 255)]; }
        const float bgk = ((const GAS float*)a.b_gk)[h * 256 + (tid & 255)];
        for (int t0 = 0; t0 < SEQ; t0 += TB) {
            __syncthreads();
#pragma unroll
            for (int rep = 0; rep < 8; ++rep) {
                const int e = tid + 512 * rep, tk = e >> 8, d = e & 255;
                const size_t trow = (size_t)b * SEQ + t0 + tk;
                sq[e] = bf2f(((const GAS bf16_t*)(ws + WS_QB))[trow * GLA_K + h * 256 + d]);
                sk[e] = bf2f(((const GAS bf16_t*)(ws + WS_KB))[trow * GLA_K + h * 256 + d]);
                float z = bgk;
                const GAS f32x4* gl = (const GAS f32x4*)((const float*)(ws + WS_GKL) + trow * 16);
#pragma unroll
                for (int r = 0; r < 4; ++r) { const f32x4 g4 = gl[r]; z += g4[0] * wg[4 * r] + g4[1] * wg[4 * r + 1] + g4[2] * wg[4 * r + 2] + g4[3] * wg[4 * r + 3]; }
                const float ls = fminf(z, 0.f) - log1pf(__expf(-fabsf(z)));
                se[e] = __expf(ls * (1.0f / 16.0f));
            }
            { const int tk = tid >> 5, cl = tid & 31;
              sv[tid] = bf2f(((const GAS bf16_t*)(ws + WS_VB))[((size_t)b * SEQ + t0 + tk) * GLA_V + h * 512 + cc * 32 + cl]); }
            __syncthreads();
#pragma unroll 4
            for (int tk = 0; tk < TB; ++tk) {
                const float v = sv[tk * 32 + col];
                float o = 0.f;
#pragma unroll
                for (int i4 = 0; i4 < 4; ++i4) {
                    const f32x4 q4 = *(const LAS f32x4*)(sq + tk * 256 + dkg * 16 + 4 * i4), k4 = *(const LAS f32x4*)(sk + tk * 256 + dkg * 16 + 4 * i4), e4 = *(const LAS f32x4*)(se + tk * 256 + dkg * 16 + 4 * i4);
#pragma unroll
                    for (int j = 0; j < 4; ++j) { S[4 * i4 + j] = e4[j] * S[4 * i4 + j] + k4[j] * v; o += q4[j] * S[4 * i4 + j]; }
                }
                o += __shfl_xor(o, 1); o += __shfl_xor(o, 2); o += __shfl_xor(o, 4); o += __shfl_xor(o, 8);
                if (dkg == 0) ((GAS float*)(ws + WS_OGLA))[((size_t)b * SEQ + t0 + tk) * GLA_V + h * 512 + cc * 32 + col] = o * (1.0f / 16.0f);
            }
        }
    }
}

struct MixSet { float ls[6][3]; unsigned ov[6][3]; u32x4 ow[4], gbw[4]; };
__device__ __forceinline__ void mix_load(MixSet& X, const unsigned char* ws, int t, int lane) {
    const int b = t >> 12, tt = t & 4095;
#pragma unroll
    for (int hh = 0; hh < 6; ++hh)
#pragma unroll
        for (int g = 0; g < 3; ++g) { const int sh = 2 * g, L = 4096 >> sh; const size_t ridx = (size_t)((g * 4 + b) * 6 + hh) * 4096 + (size_t)(tt & ((1 << sh) - 1)) * L + (tt >> sh);
            X.ls[hh][g] = ((const GAS float*)(ws + WS_LSE))[ridx]; X.ov[hh][g] = OG_FP8 ? (unsigned)((const GAS unsigned short*)(ws + WS_OG))[ridx * 64 + lane] : ((const GAS unsigned*)(ws + WS_OG))[ridx * 64 + lane]; }
#pragma unroll
    for (int h = 0; h < 4; ++h) { X.ow[h] = *(const GAS u32x4*)((const bf16_t*)(ws + WS_OGLA) + (size_t)t * GLA_V + h * 512 + 8 * lane);
        X.gbw[h] = *(const GAS u32x4*)((const bf16_t*)(ws + WS_GB) + (size_t)t * GLA_V + h * 512 + 8 * lane); }
}
__device__ __forceinline__ void mix_compute(const MixSet& X, const f32x4 g0, const f32x4 g1, unsigned char* ws, int t, int lane) {
    bf16_t* orow = (bf16_t*)(ws + WS_OCAT) + (size_t)t * KCAT;
    unsigned char* orow8 = ws + WS_OCAT + (size_t)t * KCAT;
#pragma unroll
    for (int hh = 0; hh < 6; ++hh) {
        const float mx = fmaxf(X.ls[hh][0], fmaxf(X.ls[hh][1], X.ls[hh][2]));
        const float w0 = __expf(X.ls[hh][0] - mx), w1 = __expf(X.ls[hh][1] - mx), w2 = __expf(X.ls[hh][2] - mx), inv = __builtin_amdgcn_rcpf(w0 + w1 + w2);
#if OG_FP8
        const f32x2 d0 = __builtin_amdgcn_cvt_pk_f32_fp8((int)X.ov[hh][0], false), d1 = __builtin_amdgcn_cvt_pk_f32_fp8((int)X.ov[hh][1], false), d2 = __builtin_amdgcn_cvt_pk_f32_fp8((int)X.ov[hh][2], false);
        const float o0 = (w0 * d0[0] + w1 * d1[0] + w2 * d2[0]) * (inv * (1.0f / 16.0f)), o1 = (w0 * d0[1] + w1 * d1[1] + w2 * d2[1]) * (inv * (1.0f / 16.0f));
#else
        const float o0 = (w0 * bflo(X.ov[hh][0]) + w1 * bflo(X.ov[hh][1]) + w2 * bflo(X.ov[hh][2])) * inv, o1 = (w0 * bfhi(X.ov[hh][0]) + w1 * bfhi(X.ov[hh][1]) + w2 * bfhi(X.ov[hh][2])) * inv;
#endif
#if MERGE_FP8
        ((GAS unsigned short*)orow8)[hh * 64 + lane] = (unsigned short)__builtin_amdgcn_cvt_pk_fp8_f32(clamp8(o0 * O8_SCALE), clamp8(o1 * O8_SCALE), 0, false);
#else
        ((GAS unsigned*)orow)[hh * 64 + lane] = cvtpk(o0, o1);
#endif
    }
#pragma unroll
    for (int h = 0; h < 4; ++h) {
        const u32x4 ow = X.ow[h], gbw = X.gbw[h];
        const f32x4 v0 = {bflo(ow[0]), bfhi(ow[0]), bflo(ow[1]), bfhi(ow[1])}, v1 = {bflo(ow[2]), bfhi(ow[2]), bflo(ow[3]), bfhi(ow[3])};
        float s = (v0[0] * v0[0] + v0[1] * v0[1]) + (v0[2] * v0[2] + v0[3] * v0[3]) + (v1[0] * v1[0] + v1[1] * v1[1]) + (v1[2] * v1[2] + v1[3] * v1[3]);
        const float rstd = rsqrtf(wave_sum(s) * (1.f / 512.f) + NORM_EPS);
        float gb[8] = {bflo(gbw[0]), bfhi(gbw[0]), bflo(gbw[1]), bfhi(gbw[1]), bflo(gbw[2]), bfhi(gbw[2]), bflo(gbw[3]), bfhi(gbw[3])};
        f32x4 r0, r1;
#pragma unroll
        for (int j = 0; j < 4; ++j) { r0[j] = v0[j] * rstd * g0[j] * (gb[j] * sigmoidf_(gb[j])); r1[j] = v1[j] * rstd * g1[j] * (gb[4 + j] * sigmoidf_(gb[4 + j])); }
#if MERGE_FP8
        { const f32x4 s0 = r0 * O8_SCALE, s1 = r1 * O8_SCALE;
          const u32x2 w8 = {pk4_fp8(clamp8(s0[0]), clamp8(s0[1]), clamp8(s0[2]), clamp8(s0[3])), pk4_fp8(clamp8(s1[0]), clamp8(s1[1]), clamp8(s1[2]), clamp8(s1[3]))};
          *(GAS u32x2*)(orow8 + ATT_OUT + h * 512 + 8 * lane) = w8; }
#else
        *(GAS u32x4*)(orow + ATT_OUT + h * 512 + 8 * lane) = pack8(r0, r1);
#endif
    }
}
__device__ __forceinline__ void phase_mixpost(const Args& a, int vcu, int G) {
    const int tid = threadIdx.x, lane = tid & 63, wave = tid >> 6;
    unsigned char* ws = a.ws;
    const int gw = vcu * NWAVES + wave, NGW = G * NWAVES;
    int t = gw; if (t >= T) return;
    const f32x4 g0 = *((const GAS f32x4*)(a.g_gla + 8 * lane)), g1 = *((const GAS f32x4*)(a.g_gla + 8 * lane + 4));
    MixSet A, B;
    mix_load(A, ws, t, lane);
    for (;;) {
        const int tB = t + NGW; const bool hasB = tB < T;
        mix_load(B, ws, hasB ? tB : t, lane);
        mix_compute(A, g0, g1, ws, t, lane);
        if (!hasB) break;
        const int tA = tB + NGW; const bool hasA = tA < T;
        mix_load(A, ws, hasA ? tA : tB, lane);
        mix_compute(B, g0, g1, ws, tB, lane);
        if (!hasA) break;
        t = tA;
    }
}

__device__ __forceinline__ void phase_router(const Args& a, LAS unsigned char* lds, int c, int G) {
    const int tid = threadIdx.x, lane = tid & 63, wave = __builtin_amdgcn_readfirstlane(tid >> 6), r32 = lane & 31, hi = lane >> 5;
    unsigned char* ws = a.ws;
    LAS float* P = (LAS float*)lds;
    LAS float* SS = P + 4 * 64 * 32;
    LAS unsigned* lcnt = (LAS unsigned*)(SS + 256);
    LAS unsigned* lbase = lcnt + 32;
    const float* X1 = (const float*)(ws + WS_X1);
    unsigned* cnt = (unsigned*)(ws + WS_CTL) + CW_CNT;
    for (int blk = c; blk < T / 64; blk += G) {
        const int t0 = blk * 64;
        __syncthreads();
        if (tid < 32) lcnt[tid] = 0u;
        {
            const int mb = wave & 1, kq = wave >> 1, t = t0 + 32 * mb + r32;
            const GAS float* xr = (const GAS float*)X1 + (size_t)t * DM + 512 * kq + 8 * hi;
            const GAS bf16_t* wh = (const GAS bf16_t*)(ws + WS_WRH) + (size_t)r32 * DM + 512 * kq + 8 * hi;
            const GAS bf16_t* wl = (const GAS bf16_t*)(ws + WS_WRL) + (size_t)r32 * DM + 512 * kq + 8 * hi;
            f32x16 acc = {}; float ss = 0.f;
#pragma unroll 4
            for (int ks = 0; ks < 32; ++ks) {
                const f32x4 x0 = *(const GAS f32x4*)(xr + 16 * ks), x1 = *(const GAS f32x4*)(xr + 16 * ks + 4);
                const bf16x8 bh = *(const GAS bf16x8*)(wh + 16 * ks), bl = *(const GAS bf16x8*)(wl + 16 * ks);
                ss += (x0[0] * x0[0] + x0[1] * x0[1]) + (x0[2] * x0[2] + x0[3] * x0[3]) + (x1[0] * x1[0] + x1[1] * x1[1]) + (x1[2] * x1[2] + x1[3] * x1[3]);
                u32x4 hw = {cvtpk(x0[0], x0[1]), cvtpk(x0[2], x0[3]), cvtpk(x1[0], x1[1]), cvtpk(x1[2], x1[3])};
                u32x4 lw = {cvtpk(x0[0] - bflo(hw[0]), x0[1] - bfhi(hw[0])), cvtpk(x0[2] - bflo(hw[1]), x0[3] - bfhi(hw[1])),
                            cvtpk(x1[0] - bflo(hw[2]), x1[1] - bfhi(hw[2])), cvtpk(x1[2] - bflo(hw[3]), x1[3] - bfhi(hw[3]))};
                const bf16x8 ah = *reinterpret_cast<bf16x8*>(&hw), al = *reinterpret_cast<bf16x8*>(&lw);
                acc = __builtin_amdgcn_mfma_f32_32x32x16_bf16(ah, bh, acc, 0, 0, 0);
                acc = __builtin_amdgcn_mfma_f32_32x32x16_bf16(al, bh, acc, 0, 0, 0);
                acc = __builtin_amdgcn_mfma_f32_32x32x16_bf16(ah, bl, acc, 0, 0, 0);
            }
            ss += __shfl_xor(ss, 32);
            if (hi == 0) SS[kq * 64 + 32 * mb + r32] = ss;
#pragma unroll
            for (int r = 0; r < 16; ++r) { const int row = (r & 3) + 8 * (r >> 2) + 4 * hi; P[(kq * 64 + 32 * mb + row) * 32 + r32] = acc[r]; }
        }
        __syncthreads();
        {
            const int tw = t0 + 8 * wave;
            f32x4 gffn[8];
#pragma unroll
            for (int j = 0; j < 8; ++j) gffn[j] = *((const GAS f32x4*)a.g_ffn + lane + 64 * j);
            f32x4 xa[2][8], xb[2][8];
#define RT_LOAD(buf, q0) do { _Pragma("unroll") for (int q_ = 0; q_ < 2; ++q_) _Pragma("unroll") for (int j = 0; j < 8; ++j) buf[q_][j] = ((const GAS f32x4*)(X1 + (size_t)(tw + (q0) + q_) * DM))[lane + 64 * j]; } while (0)
#define RT_STORE(buf, q0) do { _Pragma("unroll") for (int q_ = 0; q_ < 2; ++q_) { const int tk_ = 8 * wave + (q0) + q_; \
                const float rs_ = rsqrtf((SS[tk_] + SS[64 + tk_] + SS[128 + tk_] + SS[192 + tk_]) * (1.f / DM) + NORM_EPS); \
                GAS unsigned* o_ = (GAS unsigned*)(ws + WS_H2 + (size_t)(t0 + tk_) * DM) + lane; \
                _Pragma("unroll") for (int j = 0; j < 8; ++j) { const f32x4 v = buf[q_][j], g = gffn[j]; \
                    o_[64 * j] = pk4_fp8(clamp8(v[0] * rs_ * g[0]), clamp8(v[1] * rs_ * g[1]), clamp8(v[2] * rs_ * g[2]), clamp8(v[3] * rs_ * g[3])); } } } while (0)
            RT_LOAD(xa, 0); RT_LOAD(xb, 2);
            int my_e = 0; float my_g = 0.f;
            const float br = ((const GAS float*)a.b_router)[r32];
#pragma unroll
            for (int s = 0; s < 4; ++s) {
                const int tk = 8 * wave + 2 * s + hi;
                const float rstd = rsqrtf((SS[tk] + SS[64 + tk] + SS[128 + tk] + SS[192 + tk]) * (1.f / DM) + NORM_EPS);
                float lg = (P[tk * 32 + r32] + P[(64 + tk) * 32 + r32] + P[(128 + tk) * 32 + r32] + P[(192 + tk) * 32 + r32]) * rstd + br;
                float tv[4]; int te[4];
#pragma unroll
                for (int k = 0; k < 4; ++k) {
                    float bv = lg; int bi = r32;
#pragma unroll
                    for (int o = 16; o >= 1; o >>= 1) { const float ov = __shfl_xor(bv, o); const int oi = __shfl_xor(bi, o); if (ov > bv || (ov == bv && oi < bi)) { bv = ov; bi = oi; } }
                    tv[k] = bv; te[k] = bi; if (r32 == bi) lg = -__builtin_inff();
                }
                const float e1 = __expf(tv[1] - tv[0]), e2 = __expf(tv[2] - tv[0]), e3 = __expf(tv[3] - tv[0]), inv = 1.0f / (1.0f + e1 + e2 + e3);
                if ((r32 >> 2) == s) { const int k = r32 & 3;
                    my_e = k == 0 ? te[0] : (k == 1 ? te[1] : (k == 2 ? te[2] : te[3]));
                    my_g = (k == 0 ? 1.0f : (k == 1 ? e1 : (k == 2 ? e2 : e3))) * inv; }
            }
            unsigned lr = 0u;
            if (r32 < 16) lr = __hip_atomic_fetch_add(lcnt + my_e, 1u, __ATOMIC_RELAXED, __HIP_MEMORY_SCOPE_WORKGROUP);
            RT_STORE(xa, 0); RT_LOAD(xa, 4);
            __syncthreads();
            if (tid < 32) lbase[tid] = atomicAdd(cnt + tid, lcnt[tid]);
            RT_STORE(xb, 2); RT_LOAD(xb, 6);
            __syncthreads();
            if (r32 < 16) {
                const int t = tw + 2 * (r32 >> 2) + hi, k = r32 & 3;
                ((GAS int*)(ws + WS_TOPE))[t * 4 + k] = my_e; ((GAS float*)(ws + WS_TOPG))[t * 4 + k] = my_g; ((GAS int*)(ws + WS_RANK))[t * 4 + k] = (int)(lbase[my_e] + lr);
            }
            RT_STORE(xa, 4); RT_STORE(xb, 6);
#undef RT_LOAD
#undef RT_STORE
        }
    }
}

__device__ __forceinline__ void phase_scatter(const Args& a, LAS unsigned char* lds, int c, int G) {
    const int tid = threadIdx.x;
    unsigned char* ws = a.ws;
    LAS int* ps = (LAS int*)lds;
    __syncthreads();
    if (tid == 0) { int acc = 0; for (int e = 0; e < NE; ++e) { ps[e] = acc; const int cn = (int)((const GAS unsigned*)(ws + WS_CTL))[CW_CNT + e]; acc += (cn + 255) & ~255; } ps[NE] = acc; }
    __syncthreads();
    for (int i = c * 512 + tid; i < T * 4; i += G * 512) {
        const int e = ((const GAS int*)(ws + WS_TOPE))[i], rk = ((const GAS int*)(ws + WS_RANK))[i];
        const int dest = ps[e] + rk;
        ((GAS int*)(ws + WS_TOK))[dest] = i >> 2; ((GAS float*)(ws + WS_GATE))[dest] = ((const GAS float*)(ws + WS_TOPG))[i]; ((GAS int*)(ws + WS_SLOT))[i] = dest;
    }
    for (int e = c; e < NE; e += G) {
        const int cn = (int)((const GAS unsigned*)(ws + WS_CTL))[CW_CNT + e], end = ps[e + 1];
        for (int r = ps[e] + cn + tid; r < end; r += 512) { ((GAS int*)(ws + WS_TOK))[r] = 0; ((GAS float*)(ws + WS_GATE))[r] = 0.f; }
    }
    if (c == 0) {
        GAS int* te = (GAS int*)(ws + WS_TILEE);
        if (tid == 0) te[0] = ps[NE] >> 8;
        for (int rt = tid; rt < (ps[NE] >> 8); rt += 512) { int e = 0; while (e < NE - 1 && ps[e + 1] <= rt * 256) ++e; te[16 + rt] = e; }
    }
}

__device__ __forceinline__ void phase_final(const Args& a, int vcu, int G) {
    const int tid = threadIdx.x, lane = tid & 63, wave = tid >> 6;
    unsigned char* ws = a.ws;
    const int gw = vcu * NWAVES + wave, NGW = G * NWAVES;
    f32x4 gfin[4][2];
#pragma unroll
    for (int i = 0; i < 4; ++i) { const GAS f32x4* gp = (const GAS f32x4*)(a.g_final + 512 * i + 8 * lane); gfin[i][0] = gp[0]; gfin[i][1] = gp[1]; }
    for (int t = gw; t < T; t += NGW) {
        int sl[4];
#pragma unroll
        for (int k = 0; k < 4; ++k) sl[k] = __builtin_amdgcn_readfirstlane(((const GAS int*)(ws + WS_SLOT))[t * 4 + k]);
        f32x4 v[4][2]; float s = 0.f;
#pragma unroll
        for (int i = 0; i < 4; ++i) {
            const GAS f32x4* xp = (const GAS f32x4*)((const float*)(ws + WS_X1) + (size_t)t * DM + 512 * i + 8 * lane);
            v[i][0] = xp[0]; v[i][1] = xp[1];
#pragma unroll
#if Y_FP8
            for (int k = 0; k < 4; ++k) { const u32x2 yw = *(const GAS u32x2*)(ws + WS_Y + (size_t)sl[k] * DM + 512 * i + 8 * lane);
                const f32x2 a0 = __builtin_amdgcn_cvt_pk_f32_fp8((int)yw[0], false), a1 = __builtin_amdgcn_cvt_pk_f32_fp8((int)yw[0], true), a2 = __builtin_amdgcn_cvt_pk_f32_fp8((int)yw[1], false), a3 = __builtin_amdgcn_cvt_pk_f32_fp8((int)yw[1], true);
                v[i][0][0] += a0[0] * Y8_INV; v[i][0][1] += a0[1] * Y8_INV; v[i][0][2] += a1[0] * Y8_INV; v[i][0][3] += a1[1] * Y8_INV;
                v[i][1][0] += a2[0] * Y8_INV; v[i][1][1] += a2[1] * Y8_INV; v[i][1][2] += a3[0] * Y8_INV; v[i][1][3] += a3[1] * Y8_INV; }
#else
            for (int k = 0; k < 4; ++k) { const u32x4 yw = *(const GAS u32x4*)((const bf16_t*)(ws + WS_Y) + (size_t)sl[k] * DM + 512 * i + 8 * lane);
                v[i][0][0] += bflo(yw[0]); v[i][0][1] += bfhi(yw[0]); v[i][0][2] += bflo(yw[1]); v[i][0][3] += bfhi(yw[1]);
                v[i][1][0] += bflo(yw[2]); v[i][1][1] += bfhi(yw[2]); v[i][1][2] += bflo(yw[3]); v[i][1][3] += bfhi(yw[3]); }
#endif
#pragma unroll
            for (int h = 0; h < 2; ++h) s += (v[i][h][0] * v[i][h][0] + v[i][h][1] * v[i][h][1]) + (v[i][h][2] * v[i][h][2] + v[i][h][3] * v[i][h][3]);
        }
        const float rstd = rsqrtf(wave_sum(s) * (1.f / DM) + NORM_EPS);
#pragma unroll
        for (int i = 0; i < 4; ++i) {
            GAS f32x4* op = (GAS f32x4*)(a.out + (size_t)t * DM + 512 * i + 8 * lane);
            op[0] = v[i][0] * rstd * gfin[i][0]; op[1] = v[i][1] * rstd * gfin[i][1];
        }
    }
}
constexpr size_t WS_QIN = WS_ACT;
constexpr size_t WS_KST = WS_QIN + 32 * MiB;
constexpr size_t WS_VT = WS_KST + 32 * MiB;
static_assert(WS_VT == WS_VT_EARLY, "the in-projection epilogue writes the v records");
constexpr size_t WS_AB = WS_VT + 64 * MiB;
constexpr size_t WS_DEC = WS_AB + 8 * MiB;
__device__ __forceinline__ int swap23(int p) { return (p & ~12) | ((p & 4) << 1) | ((p & 8) >> 1); }

__device__ __forceinline__ void phase_gla_prep(const Args& a, LAS unsigned char* lds, int c, int G) {
    const int tid = threadIdx.x, lane = tid & 63, wave = __builtin_amdgcn_readfirstlane(tid >> 6), r32 = lane & 31, hh = lane >> 5;
    const int d = tid & 255, half = tid >> 8;
    unsigned char* ws = a.ws;
    LAS float* sg = (LAS float*)lds;
    LAS unsigned char* qal = lds + 65536;
    LAS unsigned char* kal = qal + 64 * 528;
    LAS float* sgl = (LAS float*)(lds + 65536 + 2 * 64 * 528);
    LAS float* sE = sgl + 64 * 16;
    constexpr int PITCH = 528;
    for (int I = c; I < 1024; I += G) {
        const int h = I & 3, bn = I >> 2, b = bn >> 6, n = bn & 63;
        const size_t t0 = (size_t)b * SEQ + 64 * n;
        {
            u32x4 rq[4], rk[4]; [[maybe_unused]] u32x4 rv[8];
#pragma unroll
            for (int rep = 0; rep < 4; ++rep) { const int p = tid + 512 * rep, cr = p >> 5, ch = p & 31;
                rq[rep] = *(const GAS u32x4*)((const bf16_t*)(ws + WS_QB) + (t0 + cr) * GLA_K + h * 256 + 8 * ch);
                rk[rep] = *(const GAS u32x4*)((const bf16_t*)(ws + WS_KB) + (t0 + cr) * GLA_K + h * 256 + 8 * ch); }
#if !V_RECORDS
#pragma unroll
            for (int rep = 0; rep < 8; ++rep) { const int p = tid + 512 * rep, cr = p >> 6, ch = p & 63;
                rv[rep] = *(const GAS u32x4*)((const bf16_t*)(ws + WS_VB) + (t0 + cr) * GLA_V + h * 512 + 8 * ch); }
#endif
            if (tid < 256) ((LAS f32x4*)sgl)[tid] = ((const GAS f32x4*)((const float*)(ws + WS_GKL) + t0 * 16))[tid];
#pragma unroll
            for (int rep = 0; rep < 4; ++rep) { const int p = tid + 512 * rep, cr = p >> 5, ch = p & 31;
                *(LAS u32x4*)(qal + cr * PITCH + 16 * ch) = rq[rep]; *(LAS u32x4*)(kal + cr * PITCH + 16 * ch) = rk[rep]; }
#if !V_RECORDS
#pragma unroll
            for (int rep = 0; rep < 8; ++rep) { const int p = tid + 512 * rep, cr = p >> 6, ch = p & 63;
                *(LAS u32x4*)(lds + cr * 1024 + 16 * ch) = rv[rep]; }
#endif
        }
        float wg[16];
#pragma unroll
        for (int i = 0; i < 16; ++i) wg[i] = ((const GAS float*)a.w_gk_up)[i * GLA_K + h * 256 + d];
        const float bgk = ((const GAS float*)a.b_gk)[h * 256 + d];
        __syncthreads();
#if !V_RECORDS
        {
            GAS u32x4* vo = (GAS u32x4*)((bf16_t*)(ws + WS_VT) + ((size_t)I * 16 + (tid >> 5)) * 4 * 512 + (tid & 31) * 8);
            const LAS bf16_t* vc = (const LAS bf16_t*)lds + tid;
#pragma unroll
            for (int c8 = 0; c8 < 8; ++c8) {
                unsigned short x[8];
#pragma unroll
                for (int j = 0; j < 8; ++j) x[j] = vc[(8 * c8 + j) * 512];
                u32x4 w = {(unsigned)x[0] | ((unsigned)x[1] << 16), (unsigned)x[2] | ((unsigned)x[3] << 16), (unsigned)x[4] | ((unsigned)x[5] << 16), (unsigned)x[6] | ((unsigned)x[7] << 16)};
                vo[(c8 >> 1) * 64 + (c8 & 1) * 32] = w;
            }
        }
#endif
        __syncthreads();
#pragma unroll 4
        for (int cc = 0; cc < 32; ++cc) {
            const int ct = 32 * half + cc;
            const LAS f32x4* gl = (const LAS f32x4*)(sgl + ct * 16);
            float z = bgk;
#pragma unroll
            for (int r = 0; r < 4; ++r) { const f32x4 g4 = gl[r]; z += g4[0] * wg[4 * r] + g4[1] * wg[4 * r + 1] + g4[2] * wg[4 * r + 2] + g4[3] * wg[4 * r + 3]; }
            const float ls = fminf(z, 0.f) - __logf(1.0f + __expf(-fabsf(z)));
            sg[ct * 256 + d] = ls * (1.0f / 16.0f);
        }
        __syncthreads();
        {
            float bref = 0.f, blast = 0.f;
#pragma unroll 8
            for (int ct = 0; ct < 64; ++ct) { blast += sg[ct * 256 + d]; if (ct == 32) bref = blast; }
            float bc = 0.f;
            if (half == 0) {
                sE[d] = __expf(bref);
#pragma unroll 8
                for (int ct = 0; ct < 64; ++ct) {
                    bc += sg[ct * 256 + d];
                    LAS bf16_t* qe = (LAS bf16_t*)(qal + ct * PITCH + 2 * d);
                    const float qv = bf2f(*qe) * (1.0f / 16.0f);
                    *qe = (bf16_t)(cvtpk(qv * __expf(bc - bref), 0.f) & 0xffffu);
                }
            } else {
                GAS u32x4* ko = (GAS u32x4*)((bf16_t*)(ws + WS_KST) + ((size_t)I * 8 + (d >> 5)) * 4 * 512 + (d & 31) * 8);
#pragma unroll
                for (int c8 = 0; c8 < 8; ++c8) {
                    float ks[8];
#pragma unroll
                    for (int j = 0; j < 8; ++j) {
                        const int ct = 8 * c8 + j;
                        bc += sg[ct * 256 + d];
                        LAS bf16_t* ke = (LAS bf16_t*)(kal + ct * PITCH + 2 * d);
                        const float kv = bf2f(*ke);
                        *ke = (bf16_t)(cvtpk(kv * __expf(bref - bc), 0.f) & 0xffffu);
                        ks[j] = kv * __expf(blast - bc);
                    }
                    u32x4 w = {cvtpk(ks[0], ks[1]), cvtpk(ks[2], ks[3]), cvtpk(ks[4], ks[5]), cvtpk(ks[6], ks[7])};
                    ko[(c8 >> 1) * 64 + (c8 & 1) * 32] = w;
                }
                ((GAS bf16_t*)(ws + WS_DEC))[(size_t)I * 256 + d] = (bf16_t)(cvtpk(__expf(blast), 0.f) & 0xffffu);
            }
        }
        __syncthreads();
#pragma unroll
        for (int rep = 0; rep < 4; ++rep) {
            const int p = tid + 512 * rep, R = p >> 6, L = p & 63, w_ = R >> 2, mt = (R >> 1) & 1, ks = R & 1, cq = 32 * mt + (L & 31), dk0 = 32 * w_ + 16 * ks + 4 * (L >> 5);
            const u32x2 lo = *(const LAS u32x2*)(qal + cq * PITCH + 2 * dk0), hi2 = *(const LAS u32x2*)(qal + cq * PITCH + 2 * (dk0 + 8));
            const f32x4 e0 = *(const LAS f32x4*)(sE + dk0), e1 = *(const LAS f32x4*)(sE + dk0 + 8);
            u32x4 o = {cvtpk(bflo(lo[0]) * e0[0], bfhi(lo[0]) * e0[1]), cvtpk(bflo(lo[1]) * e0[2], bfhi(lo[1]) * e0[3]),
                       cvtpk(bflo(hi2[0]) * e1[0], bfhi(hi2[0]) * e1[1]), cvtpk(bflo(hi2[1]) * e1[2], bfhi(hi2[1]) * e1[3])};
            *(GAS u32x4*)((bf16_t*)(ws + WS_QIN) + ((size_t)I * 32 + R) * 512 + L * 8) = o;
        }
        {
            const int ti = wave & 1, tj = (wave >> 1) & 1, kh = wave >> 2;
            f32x16 acc = {};
            if (!(ti == 0 && tj == 1)) {
#pragma unroll
                for (int ks = 0; ks < 8; ++ks) {
                    const bf16x8 af = *(const LAS bf16x8*)(qal + (32 * ti + r32) * PITCH + (128 * kh + 16 * ks + 8 * hh) * 2);
                    const bf16x8 bf = *(const LAS bf16x8*)(kal + (32 * tj + r32) * PITCH + (128 * kh + 16 * ks + 8 * hh) * 2);
                    acc = __builtin_amdgcn_mfma_f32_32x32x16_bf16(af, bf, acc, 0, 0, 0);
                }
            }
#pragma unroll
            for (int r = 0; r < 16; ++r) { const int row = 32 * ti + (r & 3) + 8 * (r >> 2) + 4 * hh; sg[kh * 4096 + row * 64 + 32 * tj + r32] = acc[r]; }
        }
        __syncthreads();
        {
            int ci = tid >> 3; const int cj0 = 8 * (tid & 7);
            asm volatile("" : "+v"(ci));
            float v[8];
#pragma unroll
            for (int j = 0; j < 8; ++j) { const float s = sg[ci * 64 + cj0 + j] + sg[4096 + ci * 64 + cj0 + j]; v[j] = (cj0 + j <= ci) ? s : 0.f; }
            u32x4 w = {cvtpk(v[0], v[1]), cvtpk(v[2], v[3]), cvtpk(v[4], v[5]), cvtpk(v[6], v[7])};
            *(GAS u32x4*)((bf16_t*)(ws + WS_AB) + (((size_t)I * 2 + (ci >> 5)) * 4 + ((tid & 7) >> 1)) * 512 + ((tid & 1) * 32 + (ci & 31)) * 8) = w;
        }
        __syncthreads();
    }
}

struct GlaSet { bf16x8 qf[4], kf[4], vf[4], af; u32x2 dc[4]; };
__device__ __forceinline__ void gla_load(GlaSet& X, const GAS bf16_t* qb, const GAS bf16_t* kb, const GAS bf16_t* vb, const GAS bf16_t* ab, const GAS bf16_t* db, int n, int mtw, int ksw) {
#pragma unroll
    for (int f = 0; f < 4; ++f) X.qf[f] = *(const GAS bf16x8*)(qb + (size_t)n * 4 * 32 * 512 + f * 512);
#pragma unroll
    for (int ks = 0; ks < 4; ++ks) { X.kf[ks] = *(const GAS bf16x8*)(kb + (size_t)n * 4 * 32 * 512 + ks * 512); X.vf[ks] = *(const GAS bf16x8*)(vb + (size_t)n * 4 * 64 * 512 + ks * 512); }
    X.af = *(const GAS bf16x8*)(ab + (size_t)n * 4 * 8 * 512 + (mtw * 4 + ksw) * 512);
#pragma unroll
    for (int q4 = 0; q4 < 4; ++q4) X.dc[q4] = *(const GAS u32x2*)(db + (size_t)n * 4 * 256 + 8 * q4);
}
__device__ __forceinline__ void phase_gla_seq(const Args& a, LAS unsigned char* lds, int c, int G) {
    const int tid = threadIdx.x, lane = tid & 63, w = __builtin_amdgcn_readfirstlane(tid >> 6), r32 = lane & 31, hh = lane >> 5;
    unsigned char* ws = a.ws;
    constexpr int RP = 68;
    LAS float* red = (LAS float*)lds;
    const int mtw = w & 1, ksw = w >> 1;
    for (int it = c; it < 256; it += G) {
        const int p = it >> 4, s = it & 15, b = p >> 2, h = p & 3;
        const size_t I0 = (size_t)b * 64 * 4 + h;
        const GAS bf16_t* qb = (const GAS bf16_t*)(ws + WS_QIN) + (I0 * 8 + w) * 4 * 512 + lane * 8;
        const GAS bf16_t* kb = (const GAS bf16_t*)(ws + WS_KST) + (I0 * 8 + w) * 4 * 512 + lane * 8;
        const GAS bf16_t* vb = (const GAS bf16_t*)(ws + WS_VT) + (I0 * 16 + s) * 4 * 512 + lane * 8;
        const GAS bf16_t* ab = (const GAS bf16_t*)(ws + WS_AB) + I0 * 8 * 512 + lane * 8;
        const GAS bf16_t* db = (const GAS bf16_t*)(ws + WS_DEC) + I0 * 256 + 32 * w + 4 * hh;
        GAS bf16_t* ob = (GAS bf16_t*)(ws + WS_OGLA) + ((size_t)b * SEQ + 4 * (tid >> 5)) * GLA_V + h * 512 + 32 * s + (tid & 31);
        f32x16 S = {};
        GlaSet A, B;
        gla_load(A, qb, kb, vb, ab, db, 0, mtw, ksw);
        __syncthreads();
#define GLA_STEP(X, n) do { \
            u32x4 s0 = {cvtpk(S[0], S[1]), cvtpk(S[2], S[3]), cvtpk(S[4], S[5]), cvtpk(S[6], S[7])}, s1 = {cvtpk(S[8], S[9]), cvtpk(S[10], S[11]), cvtpk(S[12], S[13]), cvtpk(S[14], S[15])}; \
            const bf16x8 sf0 = *reinterpret_cast<bf16x8*>(&s0), sf1 = *reinterpret_cast<bf16x8*>(&s1); \
            f32x16 o0 = {}, o1 = {}, U = {}; \
            o0 = __builtin_amdgcn_mfma_f32_32x32x16_bf16(X.qf[0], sf0, o0, 0, 0, 0); o0 = __builtin_amdgcn_mfma_f32_32x32x16_bf16(X.qf[1], sf1, o0, 0, 0, 0); \
            o1 = __builtin_amdgcn_mfma_f32_32x32x16_bf16(X.qf[2], sf0, o1, 0, 0, 0); o1 = __builtin_amdgcn_mfma_f32_32x32x16_bf16(X.qf[3], sf1, o1, 0, 0, 0); \
            if (mtw == 0) o0 = __builtin_amdgcn_mfma_f32_32x32x16_bf16(X.af, (ksw == 0 ? X.vf[0] : ksw == 1 ? X.vf[1] : ksw == 2 ? X.vf[2] : X.vf[3]), o0, 0, 0, 0); \
            else          o1 = __builtin_amdgcn_mfma_f32_32x32x16_bf16(X.af, (ksw == 0 ? X.vf[0] : ksw == 1 ? X.vf[1] : ksw == 2 ? X.vf[2] : X.vf[3]), o1, 0, 0, 0); \
            _Pragma("unroll") for (int ks = 0; ks < 4; ++ks) U = __builtin_amdgcn_mfma_f32_32x32x16_bf16(X.kf[ks], X.vf[ks], U, 0, 0, 0); \
            _Pragma("unroll") for (int q4 = 0; q4 < 4; ++q4) { S[4 * q4] = bflo(X.dc[q4][0]) * S[4 * q4] + U[4 * q4]; S[4 * q4 + 1] = bfhi(X.dc[q4][0]) * S[4 * q4 + 1] + U[4 * q4 + 1]; \
                S[4 * q4 + 2] = bflo(X.dc[q4][1]) * S[4 * q4 + 2] + U[4 * q4 + 2]; S[4 * q4 + 3] = bfhi(X.dc[q4][1]) * S[4 * q4 + 3] + U[4 * q4 + 3]; } \
            LAS float* rb = red + (((n) & 1) * 8 + w) * 32 * RP + r32 * RP + 4 * hh; \
            _Pragma("unroll") for (int q4 = 0; q4 < 4; ++q4) { \
                *(LAS f32x4*)(rb + 8 * q4) = (f32x4){o0[4 * q4], o0[4 * q4 + 1], o0[4 * q4 + 2], o0[4 * q4 + 3]}; \
                *(LAS f32x4*)(rb + 32 + 8 * q4) = (f32x4){o1[4 * q4], o1[4 * q4 + 1], o1[4 * q4 + 2], o1[4 * q4 + 3]}; } \
            __syncthreads(); \
            { const LAS float* rr = red + ((n) & 1) * 8 * 32 * RP + (tid & 31) * RP + 4 * (tid >> 5); f32x4 sum = *(const LAS f32x4*)rr; \
              _Pragma("unroll") for (int ww = 1; ww < 8; ++ww) sum += *(const LAS f32x4*)(rr + ww * 32 * RP); \
              const f32x4 sn = {__shfl_xor(sum[0], 1), __shfl_xor(sum[1], 1), __shfl_xor(sum[2], 1), __shfl_xor(sum[3], 1)};        \
              if ((tid & 1) == 0) { GAS bf16_t* op = ob + (size_t)(n) * 64 * GLA_V; *(GAS unsigned*)op = cvtpk(sum[0], sn[0]); *(GAS unsigned*)(op + GLA_V) = cvtpk(sum[1], sn[1]); \
                  *(GAS unsigned*)(op + 2 * GLA_V) = cvtpk(sum[2], sn[2]); *(GAS unsigned*)(op + 3 * GLA_V) = cvtpk(sum[3], sn[3]); } } \
        } while (0)
        for (int n = 0; n < 64; n += 2) {
            __builtin_amdgcn_s_waitcnt(0xF74);
            gla_load(B, qb, kb, vb, ab, db, n + 1, mtw, ksw);
            GLA_STEP(A, n);
            __builtin_amdgcn_s_waitcnt(0xF74);
            gla_load(A, qb, kb, vb, ab, db, n + 2 < 64 ? n + 2 : n, mtw, ksw);
            GLA_STEP(B, n + 1);
        }
#undef GLA_STEP
        __syncthreads();
    }
}
#ifndef MK_MULTI
#define MK_MULTI 0
#endif
constexpr int N_PHASES = 12;

union ArgsU { Args a; unsigned long long w[sizeof(Args) / 8]; };
static_assert(sizeof(Args) % 8 == 0, "Args size");
__device__ __forceinline__ Args load_args() {
    ArgsU u;
#if defined(__HIP_DEVICE_COMPILE__)
    const __attribute__((address_space(4))) unsigned long long* kp = (const __attribute__((address_space(4))) unsigned long long*)__builtin_amdgcn_kernarg_segment_ptr();
    asm volatile("" : "+s"(kp));
#pragma unroll
    for (int i = 0; i < (int)(sizeof(Args) / 8); ++i) u.w[i] = kp[i];
#endif
    return u.a;
}
#define ARGS() load_args()
__device__ __forceinline__ void run_p1(LAS unsigned char* lds, int G, int bx, int dry = 0, int ntk = DM / 64) {
    unsigned char* ws = ARGS().ws;
    { InProjSched S{(const char*)(ws + WS_H), (const char*)(ws + WS_WIN), T / 256, NT16, ntk, G, bx, (size_t)256 * DM * 2, (size_t)256 * DM * 2, false};
      EpiInProj<false> E{ws, dry, lds + 131072};
      pg8::gemm_phase<EpiInProj<false>, InProjSched, false>(lds, S, E, DM * 2, DM * 2); }
    { const int c8 = (bx + ((T / 256) * NT8) % G) % G;
      InProjSched S{(const char*)(ws + WS_H8), (const char*)(ws + WS_WIN8), T / 256, NT8, ntk / 2, G, c8, (size_t)256 * DM, (size_t)256 * DM, true};
      EpiInProj<true> E{ARGS().ws, dry};
      pg8::gemm_phase<EpiInProj<true>, InProjSched, false, true>(lds, S, E, DM, DM); }
}
__device__ __forceinline__ void run_p5(LAS unsigned char* lds, int G, int bx) {
    unsigned char* ws = ARGS().ws;
    constexpr int EB = MERGE_FP8 ? 1 : 2;
    MergeSched S{(const char*)(ws + WS_OCAT), (const char*)(ws + WS_WM), T / 256, DM / 256, G, bx, (size_t)256 * KCAT * EB, (size_t)256 * KCAT * EB};
    EpiMerge E{ws};
    pg8::gemm_phase<EpiMerge, MergeSched, false, MERGE_FP8 != 0>(lds, S, E, KCAT * EB, KCAT * EB);
}
__device__ __forceinline__ void run_p6(LAS unsigned char* lds, int G, int bx, bool dry = false) {
    const Args args = ARGS(); unsigned char* ws = args.ws;
    DenseSched S{(const char*)(ws + WS_MRG), (const char*)(ws + WS_WO), T / 256, DM / 256, DM / 64, G, bx, (size_t)256 * DM * 2, (size_t)256 * DM * 2};
    EpiOut E{args.x, (float*)(ws + WS_X1), dry};
    pg8::gemm_phase<EpiOut, DenseSched, false>(lds, S, E, DM * 2, DM * 2);
}
__device__ __forceinline__ void run_p9(LAS unsigned char* lds, int G, int bx, bool dry = false, int ntk = 16) {
    const Args args = ARGS(); unsigned char* ws = args.ws;
#if MOE_FP8
    MoeSched S{(const char*)(ws + WS_H2), (const char*)(ws + WS_W1), load_tile_table(lds, ws), (const int*)(ws + WS_TOK), 16, G, bx, 0, (size_t)256 * DM, (size_t)4096 * DM, true, ntk};
    EpiMoe1 E{args.b_mlp1, (bf16_t*)(ws + WS_ACT), dry};
    pg8::gemm_phase<EpiMoe1, MoeSched, true, true>(lds, S, E, DM, DM);
#else
    MoeSched S{(const char*)(ws + WS_H2), (const char*)(ws + WS_W1), load_tile_table(lds, ws), (const int*)(ws + WS_TOK), 16, G, bx, 0, (size_t)256 * DM * 2, (size_t)4096 * DM * 2, true, 32};
    EpiMoe1 E{args.b_mlp1, (bf16_t*)(ws + WS_ACT), dry};
    pg8::gemm_phase<EpiMoe1, MoeSched, true>(lds, S, E, DM * 2, DM * 2);
#endif
}
__device__ __forceinline__ void run_p10(LAS unsigned char* lds, int G, int bx, bool dry = false) {
    const Args args = ARGS(); unsigned char* ws = args.ws;
#if MOE_FP8
    MoeSched S{(const char*)(ws + WS_ACT), (const char*)(ws + WS_W2), load_tile_table(lds, ws), (const int*)(ws + WS_TOK), 8, G, bx, (size_t)256 * DFF, (size_t)256 * DFF, (size_t)DM * DFF, false, 16};
    EpiMoe2 E{args.b_mlp2, (const float*)(ws + WS_GATE), (bf16_t*)(ws + WS_Y), dry};
    pg8::gemm_phase<EpiMoe2, MoeSched, false, true>(lds, S, E, DFF, DFF);
#else
    MoeSched S{(const char*)(ws + WS_ACT), (const char*)(ws + WS_W2), load_tile_table(lds, ws), (const int*)(ws + WS_TOK), 8, G, bx, (size_t)256 * DFF * 2, (size_t)256 * DFF * 2, (size_t)DM * DFF * 2, false, 32};
    EpiMoe2 E{args.b_mlp2, (const float*)(ws + WS_GATE), (bf16_t*)(ws + WS_Y)};
    pg8::gemm_phase<EpiMoe2, MoeSched, false>(lds, S, E, DFF * 2, DFF * 2);
#endif
}

#ifndef PHASE_MASK
#define PHASE_MASK 0xFFF
#endif
#ifndef EXP_DRY
#define EXP_DRY 1
#endif
#ifndef EXP_DRY9
#define EXP_DRY9 true
#endif
#ifndef EXP_NTK9
#define EXP_NTK9 16
#endif
#ifndef EXP_NTK
#define EXP_NTK (DM / 64)
#endif
#ifndef REPEAT_MASK
#define REPEAT_MASK 0
#endif
__global__ void __launch_bounds__(NWAVES * 64, 2) mega(Args args_unused) {
    extern __shared__ __attribute__((aligned(16))) unsigned char lds_raw[];
    LAS unsigned char* lds = (LAS unsigned char*)lds_raw;
    const int tid = threadIdx.x;
    const int G = gridDim.x, bx = blockIdx.x;
#define vcu ((int)((gridDim.x % 8 == 0) ? (blockIdx.x % 8) * (gridDim.x / 8) + blockIdx.x / 8 : blockIdx.x))
    volatile LAS unsigned* MISC = (volatile LAS unsigned*)(lds + MISC_OFF);
    if (tid < 16) MISC[tid] = 0u;
    __syncthreads();
    { const Args a0 = ARGS();
      if (tid == 0) (void)xb_add((unsigned*)(a0.ws + WS_CTL) + CW_BAR + XB_XCNT(xb_xcc_id()), 1u); }
#define lo (ARGS().ph_lo)
#define hi (ARGS().ph_hi)
#define IN(k) ((((PHASE_MASK) >> (k)) & 1) && lo <= (k) && (k) < hi)
#define BOTH(k) (IN(k) && IN((k) + 1))
#define REP(k) (((REPEAT_MASK) >> (k)) & 1)
#define GRID_BAR() do { XcdBarrier bar_; bar_.bar = (unsigned*)(ARGS().ws + WS_CTL) + CW_BAR; bar_.x = xb_xcc_id(); bar_.st = MISC + 8; xcd_barrier(bar_); } while (0)
#define PHASE(k, call) do { if (IN(k)) { call; if (REP(k)) { GRID_BAR(); call; } if (BOTH(k)) GRID_BAR(); } } while (0)

    PHASE(0, phase_prologue(ARGS(), lds, vcu, G));
    if (IN(1)) {
#if CVT_SPLIT
        if ((int)blockIdx.x < G - NCVT) run_p1(lds, G - NCVT, bx, 0);
        else phase_cvt_experts(ARGS(), lds, (int)blockIdx.x - (G - NCVT), NCVT);
#else
        run_p1(lds, G, bx, 0);
#endif
        if (REP(1)) { GRID_BAR(); run_p1(lds, G, bx, EXP_DRY, EXP_NTK); } if (BOTH(1)) GRID_BAR(); }
#if defined(GLA_NAIVE)
    if (IN(2)) { phase_attention(ARGS(), (char*)lds_raw, bx, G); __syncthreads(); }
    PHASE(3, phase_gla(ARGS(), lds, vcu, G));
#else
    if (IN(2)) { phase_attention(ARGS(), (char*)lds_raw, bx, G); __syncthreads(); if (REP(2)) { phase_attention(ARGS(), (char*)lds_raw, bx, G); __syncthreads(); } }
    { int two = 2; asm volatile("" : "+s"(two));
      if (((PHASE_MASK >> 2) & 1) && lo <= two && two < hi) { phase_gla_prep(ARGS(), lds, vcu, G); if (REP(2)) phase_gla_prep(ARGS(), lds, vcu, G); if (BOTH(2)) GRID_BAR(); } }
    PHASE(3, phase_gla_seq(ARGS(), lds, vcu, G));
#endif
    PHASE(4, phase_mixpost(ARGS(), vcu, G));
#ifdef EXTRA_BARS
    for (int xb_ = 0; xb_ < EXTRA_BARS; ++xb_) GRID_BAR();
#endif
    PHASE(5, run_p5(lds, G, bx));
    if (IN(6)) { run_p6(lds, G, bx, false); if (REP(6)) { GRID_BAR(); run_p6(lds, G, bx, EXP_DRY); } if (BOTH(6)) GRID_BAR(); }
    PHASE(7, phase_router(ARGS(), lds, vcu, G));
    PHASE(8, phase_scatter(ARGS(), lds, vcu, G));
    if (IN(9)) { run_p9(lds, G, bx, false); if (REP(9)) { GRID_BAR(); run_p9(lds, G, bx, EXP_DRY9, EXP_NTK9); } if (BOTH(9)) GRID_BAR(); }
    if (IN(10)) { run_p10(lds, G, bx, false); if (REP(10)) { GRID_BAR(); run_p10(lds, G, bx, true); } if (BOTH(10)) GRID_BAR(); }
    if (IN(11)) { phase_final(ARGS(), vcu, G); if (REP(11)) phase_final(ARGS(), vcu, G); }
#undef IN
#undef BOTH
#undef GRID_BAR
#undef lo
#undef hi
#undef vcu
}

extern "C" void kernel_launch(void* const* d_in, const int* in_sizes, int n_in, void* d_out, int out_size, void* d_ws, size_t ws_size, hipStream_t stream) {
    static int grid = 0;
    if (grid == 0) {
        if (n_in != 18 || out_size != T * DM || ws_size < WS_END) { fprintf(stderr, "kernel_launch: unexpected shapes (n_in %d out %d ws %zu need %zu)\n", n_in, out_size, ws_size, (size_t)WS_END); grid = -1; return; }
        int dev = 0, cus = 0;
        if (hipGetDevice(&dev) != hipSuccess || hipDeviceGetAttribute(&cus, hipDeviceAttributeMultiprocessorCount, dev) != hipSuccess) { grid = -1; return; }
        if (hipFuncSetAttribute((const void*)mega, hipFuncAttributeMaxDynamicSharedMemorySize, LDS_BYTES) != hipSuccess) { fprintf(stderr, "kernel_launch: hipFuncSetAttribute failed\n"); grid = -1; return; }
        int per_cu = 0;
        if (hipOccupancyMaxActiveBlocksPerMultiprocessor(&per_cu, (const void*)mega, NWAVES * 64, LDS_BYTES) != hipSuccess || per_cu < 1) fprintf(stderr, "kernel_launch: occupancy query says %d\n", per_cu);
        (void)hipGetLastError();
        grid = cus;
    }
    if (grid < 0) return;
    (void)hipMemsetAsync((char*)d_ws + WS_CTL, 0, CTL_ZERO_BYTES, stream);
    Args a{};
    a.x = (const float*)d_in[0]; a.pos = (const int*)d_in[1]; a.g_mix = (const float*)d_in[2]; a.w_in = (const float*)d_in[3]; a.w_gk_up = (const float*)d_in[4];
    a.b_gk = (const float*)d_in[5]; a.g_gla = (const float*)d_in[6]; a.w_oa = (const float*)d_in[7]; a.w_ob = (const float*)d_in[8]; a.w_out = (const float*)d_in[9];
    a.g_ffn = (const float*)d_in[10]; a.w_router = (const float*)d_in[11]; a.b_router = (const float*)d_in[12]; a.w_mlp1 = (const float*)d_in[13]; a.b_mlp1 = (const float*)d_in[14];
    a.w_mlp2 = (const float*)d_in[15]; a.b_mlp2 = (const float*)d_in[16]; a.g_final = (const float*)d_in[17];
    a.out = (float*)d_out; a.ws = (unsigned char*)d_ws;
#if MK_MULTI
    for (int p = 0; p < N_PHASES; ++p) { a.ph_lo = p; a.ph_hi = p + 1; hipLaunchKernelGGL(mega, dim3(grid), dim3(NWAVES * 64), LDS_BYTES, stream, a); }
#else
    a.ph_lo = 0; a.ph_hi = N_PHASES; hipLaunchKernelGGL(mega, dim3(grid), dim3(NWAVES * 64), LDS_BYTES, stream, a);
#endif
}
```
